# Optimizing an MI355X kernel written in HIP

```python
import math
import jax, jax.numpy as jnp
from jax import lax
import numpy as np

D_MODEL = 1024
BATCH = 8
SEQ = 4096
DEPTH = 1

MEM_LEN = 256
MLA_HEADS = 8
MLA_Q_RANK = 384
MLA_KV_RANK = 128
MLA_NOPE = 64
MLA_ROPE = 32
MLA_V = 64
Q_BLOCK = 128
RET_HEADS = 4
RET_DK = 64
RET_DV = 128
RET_CHUNK = 128
X_HEADS = 4
X_DH = 128
N_BRANCH = 3
PEER_HEADS = 8
PEER_N_KEYS = 128
PEER_N_EXPERTS = PEER_N_KEYS * PEER_N_KEYS
PEER_TOPK = 16
PEER_DQ = 256
PEER_DHALF = PEER_DQ // 2
PEER_TOKEN_BLOCK = 128

ROPE_BASE = 10000.0
EPS = 1e-6
IN_SPLITS = (MLA_Q_RANK, MLA_KV_RANK, MLA_ROPE,
             RET_HEADS * RET_DK, RET_HEADS * RET_DK, RET_HEADS * RET_DV, RET_HEADS * RET_DV,
             X_HEADS * X_DH, N_BRANCH * D_MODEL)
IN_COLS = sum(IN_SPLITS)

kernel_name = "hybrid_mla_retention_memxattn_peer"


def rmsnorm(x, g):
    xf = x.astype(jnp.float32)
    y = xf * lax.rsqrt(jnp.mean(xf * xf, axis=-1, keepdims=True) + EPS)
    return (y * g.astype(jnp.float32)).astype(x.dtype)


def rope(x, positions):
    d = x.shape[-1]
    inv_freq = ROPE_BASE ** (-jnp.arange(0, d, 2, dtype=jnp.float32) / d)
    ang = positions.astype(jnp.float32)[..., None] * inv_freq
    cos = jnp.cos(ang)[:, :, None, :].astype(x.dtype)
    sin = jnp.sin(ang)[:, :, None, :].astype(x.dtype)
    x1, x2 = x[..., : d // 2], x[..., d // 2:]
    return jnp.concatenate([x1 * cos - x2 * sin, x1 * sin + x2 * cos], axis=-1)


def causal_attention_blocked(q, k, v, scale):
    B, H, S, dqk = q.shape
    nb = S // Q_BLOCK
    qb = q.reshape(B, H, nb, Q_BLOCK, dqk).transpose(2, 0, 1, 3, 4)
    kpos = jnp.arange(S)

    def one_block(args):
        q_blk, bi = args
        qpos = bi * Q_BLOCK + jnp.arange(Q_BLOCK)
        s = jnp.einsum('bhqd,bhkd->bhqk', q_blk, k).astype(jnp.float32) * scale
        s = jnp.where(kpos[None, :] <= qpos[:, None], s, jnp.float32(-1e30))
        p = jax.nn.softmax(s, axis=-1).astype(v.dtype)
        return jnp.einsum('bhqk,bhkd->bhqd', p, v)

    o = lax.map(one_block, (qb, jnp.arange(nb)))
    return o.transpose(1, 2, 0, 3, 4).reshape(B, H, S, v.shape[-1])


def mla_branch(c_q, c_kv, k_r, positions, q_norm_g, w_uq, kv_norm_g, w_ukv, qn_g, kn_g, w_o):
    B, S, _ = c_q.shape
    q = (rmsnorm(c_q, q_norm_g) @ w_uq).reshape(B, S, MLA_HEADS, MLA_NOPE + MLA_ROPE)
    kv = (rmsnorm(c_kv, kv_norm_g) @ w_ukv).reshape(B, S, MLA_HEADS, MLA_NOPE + MLA_V)
    k_nope, v = kv[..., :MLA_NOPE], kv[..., MLA_NOPE:]
    k_rope = jnp.broadcast_to(k_r[:, :, None, :], (B, S, MLA_HEADS, MLA_ROPE))
    k = jnp.concatenate([k_nope, k_rope], axis=-1)
    q = rmsnorm(q, qn_g)
    k = rmsnorm(k, kn_g)
    q = jnp.concatenate([q[..., :MLA_NOPE], rope(q[..., MLA_NOPE:], positions)], axis=-1)
    k = jnp.concatenate([k[..., :MLA_NOPE], rope(k[..., MLA_NOPE:], positions)], axis=-1)
    scale = (MLA_NOPE + MLA_ROPE) ** -0.5
    o = causal_attention_blocked(q.transpose(0, 2, 1, 3), k.transpose(0, 2, 1, 3),
                                 v.transpose(0, 2, 1, 3), scale)
    o = o.transpose(0, 2, 1, 3).reshape(B, S, MLA_HEADS * MLA_V)
    return o @ w_o


def retention_chunkwise(q, k, v, log_gamma):
    B, H, S, dk = q.shape
    dv = v.shape[-1]
    L = RET_CHUNK
    C = S // L
    dt = q.dtype
    qc = q.reshape(B, H, C, L, dk)
    kc = k.reshape(B, H, C, L, dk)
    vc = v.reshape(B, H, C, L, dv)
    idx = jnp.arange(L, dtype=jnp.float32)
    diff = idx[:, None] - idx[None, :]
    lg = log_gamma[:, None, None]
    decay = jnp.where(diff >= 0, jnp.exp(lg * jnp.maximum(diff, 0.0)), 0.0).astype(dt)
    xi = jnp.exp(log_gamma[:, None] * (idx + 1.0)).astype(dt)
    zeta = jnp.exp(log_gamma[:, None] * (L - 1.0 - idx)).astype(dt)
    inner = jnp.einsum('bhcid,bhcjd->bhcij', qc, kc) * decay[None, :, None]
    inner_out = jnp.einsum('bhcij,bhcje->bhcie', inner, vc)
    incr = jnp.einsum('bhcjd,bhcje->cbhde', kc * zeta[None, :, None, :, None], vc)
    chunk_decay = jnp.exp(log_gamma * L).astype(incr.dtype)[None, :, None, None]

    def step(R, inc):
        return chunk_decay * R + inc, R

    _, R_prev = lax.scan(step, jnp.zeros((B, H, dk, dv), incr.dtype), incr)
    cross = jnp.einsum('bhcid,cbhde->bhcie', qc * xi[None, :, None, :, None], R_prev)
    return (inner_out + cross).reshape(B, H, S, dv)


def retention_branch(r_q, r_k, r_v, r_g, positions, gn_g, w_o):
    B, S, _ = r_q.shape
    q = rope(r_q.reshape(B, S, RET_HEADS, RET_DK), positions)
    k = rope(r_k.reshape(B, S, RET_HEADS, RET_DK), positions) * (RET_DK ** -0.5)
    v = r_v.reshape(B, S, RET_HEADS, RET_DV)
    log_gamma = jnp.log(1.0 - 2.0 ** (-5.0 - jnp.arange(RET_HEADS, dtype=jnp.float32)))
    o = retention_chunkwise(q.transpose(0, 2, 1, 3), k.transpose(0, 2, 1, 3),
                            v.transpose(0, 2, 1, 3), log_gamma)
    o = rmsnorm(o.transpose(0, 2, 1, 3), gn_g)
    o = o.reshape(B, S, RET_HEADS * RET_DV) * jax.nn.silu(r_g)
    return o @ w_o


def memory_branch(x_q, mem, mem_g, w_mem_kv, qn_g, kn_g, w_o):
    B, S, _ = x_q.shape
    M = mem.shape[1]
    q = rmsnorm(x_q.reshape(B, S, X_HEADS, X_DH), qn_g)
    kv = (rmsnorm(mem, mem_g) @ w_mem_kv).reshape(B, M, X_HEADS, 2 * X_DH)
    k = rmsnorm(kv[..., :X_DH], kn_g)
    v = kv[..., X_DH:]
    s = jnp.einsum('bshd,bmhd->bhsm', q, k).astype(jnp.float32) * (X_DH ** -0.5)
    p = jax.nn.softmax(s, axis=-1).astype(v.dtype)
    o = jnp.einsum('bhsm,bmhd->bshd', p, v).reshape(B, S, X_HEADS * X_DH)
    return o @ w_o


def peer_ffn(xn, w_q, sub_keys, u_tab, v_tab):
    B, S, D = xn.shape
    T = B * S
    xt = xn.reshape(T, D)
    q = (xt @ w_q).reshape(T, PEER_HEADS, 2, PEER_DHALF)
    s = jnp.einsum('thcd,hcnd->thcn', q, sub_keys)
    sv, si = lax.top_k(s, PEER_TOPK)
    cand = (sv[:, :, 0, :, None] + sv[:, :, 1, None, :]).reshape(T, PEER_HEADS, PEER_TOPK * PEER_TOPK)
    cand_idx = (si[:, :, 0, :, None] * PEER_N_KEYS + si[:, :, 1, None, :]).reshape(
        T, PEER_HEADS, PEER_TOPK * PEER_TOPK)
    best, pos = lax.top_k(cand, PEER_TOPK)
    experts = jnp.take_along_axis(cand_idx, pos, axis=-1)
    gate = jax.nn.softmax(best.astype(jnp.float32), axis=-1).astype(xn.dtype)
    nb = T // PEER_TOKEN_BLOCK

    def one_block(args):
        xb, eb, gb = args
        u = u_tab[eb]
        a = jax.nn.gelu(jnp.einsum('thkd,td->thk', u, xb))
        vv = v_tab[eb]
        return jnp.einsum('thk,thkd->td', gb * a, vv)

    out = lax.map(one_block, (xt.reshape(nb, PEER_TOKEN_BLOCK, D),
                              experts.reshape(nb, PEER_TOKEN_BLOCK, PEER_HEADS, PEER_TOPK),
                              gate.reshape(nb, PEER_TOKEN_BLOCK, PEER_HEADS, PEER_TOPK)))
    return out.reshape(B, S, D)


def setup_inputs(seed: int = 0) -> dict:
    key = jax.random.key(seed)
    ks = jax.random.split(key, 32)
    f32 = jnp.float32

    def nrm(k, shape, scale):
        return jax.random.normal(k, shape, f32) * scale

    def gain(k, shape):
        return 1.0 + 0.02 * jax.random.normal(k, shape, f32)

    start = jax.random.randint(ks[2], (BATCH, 1), 0, 1024, dtype=jnp.int32)
    positions = (start + jnp.arange(SEQ, dtype=jnp.int32)[None, :]).astype(jnp.int32)
    return {
        "x": nrm(ks[0], (BATCH, SEQ, D_MODEL), 1.0),
        "mem": nrm(ks[1], (BATCH, MEM_LEN, D_MODEL), 1.0),
        "positions": positions,
        "attn_norm_g": gain(ks[3], (DEPTH, D_MODEL)),
        "w_in": nrm(ks[4], (DEPTH, D_MODEL, IN_COLS), D_MODEL ** -0.5),
        "mla_q_norm_g": gain(ks[5], (DEPTH, MLA_Q_RANK)),
        "w_uq": nrm(ks[6], (DEPTH, MLA_Q_RANK, MLA_HEADS * (MLA_NOPE + MLA_ROPE)), MLA_Q_RANK ** -0.5),
        "mla_kv_norm_g": gain(ks[7], (DEPTH, MLA_KV_RANK)),
        "w_ukv": nrm(ks[8], (DEPTH, MLA_KV_RANK, MLA_HEADS * (MLA_NOPE + MLA_V)), MLA_KV_RANK ** -0.5),
        "mla_qn_g": gain(ks[9], (DEPTH, MLA_NOPE + MLA_ROPE)),
        "mla_kn_g": gain(ks[10], (DEPTH, MLA_NOPE + MLA_ROPE)),
        "w_o_mla": nrm(ks[11], (DEPTH, MLA_HEADS * MLA_V, D_MODEL), (MLA_HEADS * MLA_V) ** -0.5),
        "ret_gn_g": gain(ks[12], (DEPTH, RET_HEADS, RET_DV)),
        "w_o_ret": nrm(ks[13], (DEPTH, RET_HEADS * RET_DV, D_MODEL), (RET_HEADS * RET_DV) ** -0.5),
        "mem_norm_g": gain(ks[14], (DEPTH, D_MODEL)),
        "w_mem_kv": nrm(ks[15], (DEPTH, D_MODEL, X_HEADS * 2 * X_DH), D_MODEL ** -0.5),
        "x_qn_g": gain(ks[16], (DEPTH, X_DH)),
        "x_kn_g": gain(ks[17], (DEPTH, X_DH)),
        "w_o_cross": nrm(ks[18], (DEPTH, X_HEADS * X_DH, D_MODEL), (X_HEADS * X_DH) ** -0.5),
        "w_out": nrm(ks[19], (DEPTH, D_MODEL, D_MODEL), D_MODEL ** -0.5),
        "ffn_norm_g": gain(ks[20], (DEPTH, D_MODEL)),
        "peer_w_q": nrm(ks[21], (DEPTH, D_MODEL, PEER_HEADS * PEER_DQ), D_MODEL ** -0.5),
        "peer_keys": nrm(ks[22], (DEPTH, PEER_HEADS, 2, PEER_N_KEYS, PEER_DHALF), PEER_DHALF ** -0.5),
        "peer_u": nrm(ks[23], (DEPTH, PEER_N_EXPERTS, D_MODEL), D_MODEL ** -0.5),
        "peer_v": nrm(ks[24], (DEPTH, PEER_N_EXPERTS, D_MODEL), (PEER_HEADS * PEER_TOPK) ** -0.5),
    }


def reference(x, mem, positions, attn_norm_g, w_in, mla_q_norm_g, w_uq, mla_kv_norm_g, w_ukv,
              mla_qn_g, mla_kn_g, w_o_mla, ret_gn_g, w_o_ret, mem_norm_g, w_mem_kv, x_qn_g, x_kn_g,
              w_o_cross, w_out, ffn_norm_g, peer_w_q, peer_keys, peer_u, peer_v):
    B, S, _ = x.shape
    split_points = []
    acc = 0
    for sz in IN_SPLITS[:-1]:
        acc += sz
        split_points.append(acc)
    h = x
    for layer in range(DEPTH):
        n = rmsnorm(h, attn_norm_g[layer])
        proj = n @ w_in[layer]
        c_q, c_kv, k_r, r_q, r_k, r_v, r_g, x_q, gates = jnp.split(proj, split_points, axis=-1)
        y_mla = mla_branch(c_q, c_kv, k_r, positions, mla_q_norm_g[layer], w_uq[layer],
                           mla_kv_norm_g[layer], w_ukv[layer], mla_qn_g[layer], mla_kn_g[layer],
                           w_o_mla[layer])
        y_ret = retention_branch(r_q, r_k, r_v, r_g, positions, ret_gn_g[layer], w_o_ret[layer])
        y_mem = memory_branch(x_q, mem, mem_norm_g[layer], w_mem_kv[layer], x_qn_g[layer],
                              x_kn_g[layer], w_o_cross[layer])
        g = jax.nn.sigmoid(gates.reshape(B, S, N_BRANCH, D_MODEL))
        merged = g[:, :, 0] * y_mla + g[:, :, 1] * y_ret + g[:, :, 2] * y_mem
        h = h + merged @ w_out[layer]
        h = h + peer_ffn(rmsnorm(h, ffn_norm_g[layer]), peer_w_q[layer], peer_keys[layer],
                         peer_u[layer], peer_v[layer])
    return h
```

```cpp
#include <hip/hip_runtime.h>
#include <cstdio>
#include <cstdint>
#include <cmath>

#define LAS __attribute__((address_space(3)))
#define GAS __attribute__((address_space(1)))
typedef unsigned short bf16_t;
typedef short bf16x8 __attribute__((ext_vector_type(8)));
typedef float f32x4 __attribute__((ext_vector_type(4)));
typedef float f32x2 __attribute__((ext_vector_type(2)));
typedef float f32x16 __attribute__((ext_vector_type(16)));
typedef unsigned u32x4 __attribute__((ext_vector_type(4)));
typedef unsigned u32x2 __attribute__((ext_vector_type(2)));

#ifndef DBG_ZERO
#define DBG_ZERO 0
#endif
#ifndef DBG_CHECK
#define DBG_CHECK 0
#endif
#ifndef MK_PER_PHASE
#define MK_PER_PHASE 0
#endif

constexpr int T_ = 32768, S_ = 4096, B_ = 8, D_ = 1024, MEM_ = 256;
constexpr int NPA = 2816;
constexpr int NGT = 3072;
constexpr int NG1 = NPA + NGT;
constexpr int NUP = 1792;
constexpr float EPS_ = 1e-6f;
constexpr float LOG2E = 1.4426950408889634f;
constexpr int NPOS = 5120;
constexpr int NPHASE = 12;

constexpr size_t MiB = 1u << 20;
constexpr size_t WS_CTL = 0, CTL_ZERO_BYTES = 1 * MiB;
constexpr size_t WS_WIN = 1 * MiB;
constexpr size_t WS_WUP = 13 * MiB;
constexpr size_t WS_WO3 = 15 * MiB;
constexpr size_t WS_WOUT = 18 * MiB;
constexpr size_t WS_WMKV = 20 * MiB;
constexpr size_t WS_WQ = 22 * MiB;
constexpr size_t WS_KEYS = 26 * MiB;
constexpr size_t WS_CS32 = 27 * MiB;
constexpr size_t WS_CS64 = 27 * MiB + 655360;
constexpr size_t WS_MEMN = 29 * MiB;
constexpr size_t WS_KVM = 33 * MiB;
constexpr size_t WS_KX = 37 * MiB;
constexpr size_t WS_VXT = 39 * MiB;
constexpr size_t WS_RA = 48 * MiB;
constexpr size_t WS_UP = WS_RA;
constexpr size_t WS_VMT = WS_RA + 112 * MiB;
constexpr size_t WS_OMLA = WS_RA + 144 * MiB;
constexpr size_t WS_RB = 224 * MiB;
constexpr size_t WS_RC = 416 * MiB;
constexpr size_t WS_QRET = WS_RC;
constexpr size_t WS_KRET = WS_RC + 16 * MiB;
constexpr size_t WS_KRETT = WS_RC + 32 * MiB;
constexpr size_t WS_INCR = WS_RC + 48 * MiB;
constexpr size_t WS_KR = WS_RC + 80 * MiB;
constexpr size_t WS_XN = WS_RA;
constexpr size_t WS_UBF = WS_RA + 64 * MiB;
constexpr size_t WS_VBF = WS_RA + 96 * MiB;
constexpr size_t WS_PQ = WS_RB;
constexpr size_t WS_SC = WS_RB + 128 * MiB;
constexpr size_t WS_END = 512 * MiB;
constexpr size_t DO_N = 0, DO_CQKV = 0, DO_GS = 32 * MiB, DO_XQ = 64 * MiB, DO_VRT = 96 * MiB;

constexpr int LDS_BYTES = 147456;
constexpr int MISC_OFF = LDS_BYTES - 64;

struct Args {
    const float* x; const float* mem; const int* pos;
    const float *attn_norm_g, *w_in, *mla_q_norm_g, *w_uq, *mla_kv_norm_g, *w_ukv, *mla_qn_g, *mla_kn_g, *w_o_mla,
                *ret_gn_g, *w_o_ret, *mem_norm_g, *w_mem_kv, *x_qn_g, *x_kn_g, *w_o_cross, *w_out, *ffn_norm_g,
                *peer_w_q, *peer_keys, *peer_u, *peer_v;
    float* out; unsigned char* ws;
    float invf32[16]; float invf64[32]; float lg2g[4];
    int ph_lo, ph_hi;
};

__device__ __forceinline__ unsigned f2bf(float f) { unsigned u = __builtin_bit_cast(unsigned, f); return (u + 0x7fffu + ((u >> 16) & 1u)) >> 16; }
__device__ __forceinline__ unsigned pk2(float lo, float hi) { return f2bf(lo) | (f2bf(hi) << 16); }
__device__ __forceinline__ float bflo(unsigned u) { return __builtin_bit_cast(float, u << 16); }
__device__ __forceinline__ float bfhi(unsigned u) { return __builtin_bit_cast(float, u & 0xffff0000u); }
__device__ __forceinline__ float bf1(bf16_t v) { return __builtin_bit_cast(float, ((unsigned)v) << 16); }
__device__ __forceinline__ float ex2(float x) { return __builtin_amdgcn_exp2f(x); }
__device__ __forceinline__ float rsq(float x) { return __builtin_amdgcn_rsqf(x); }
__device__ __forceinline__ float rcp(float x) { return __builtin_amdgcn_rcpf(x); }
__device__ __forceinline__ float sigmoidf_(float x) { return rcp(1.f + ex2(-x * LOG2E)); }
__device__ __forceinline__ float gelu_tanh(float x) { const float u = 0.7978845608028654f * (x + 0.044715f * x * x * x); return x * rcp(1.f + ex2(-2.f * LOG2E * u)); }
__device__ __forceinline__ float wave_sum(float v) {
#pragma unroll
    for (int o = 1; o < 64; o <<= 1) v += __shfl_xor(v, o);
    return v;
}
__device__ __forceinline__ float sum16(float v) {
#pragma unroll
    for (int o = 1; o < 16; o <<= 1) v += __shfl_xor(v, o);
    return v;
}
__device__ __forceinline__ void unpack8(const u32x4 w, float (&f)[8]) {
    f[0] = bflo(w.x); f[1] = bfhi(w.x); f[2] = bflo(w.y); f[3] = bfhi(w.y); f[4] = bflo(w.z); f[5] = bfhi(w.z); f[6] = bflo(w.w); f[7] = bfhi(w.w);
}
__device__ __forceinline__ u32x4 pack8(const float (&f)[8]) { u32x4 w; w.x = pk2(f[0], f[1]); w.y = pk2(f[2], f[3]); w.z = pk2(f[4], f[5]); w.w = pk2(f[6], f[7]); return w; }
__device__ __forceinline__ int crow(int r, int hi) { return (r & 3) + 8 * (r >> 2) + 4 * hi; }
__device__ __forceinline__ f32x16 mfma32(bf16x8 a, bf16x8 b, f32x16 c) { return __builtin_amdgcn_mfma_f32_32x32x16_bf16(a, b, c, 0, 0, 0); }
__device__ __forceinline__ float xmax32(float m) { return fmaxf(m, __shfl_xor(m, 32)); }
__device__ __forceinline__ float xsum32(float m) { return m + __shfl_xor(m, 32); }
#define F16Z ((f32x16){0.f,0.f,0.f,0.f,0.f,0.f,0.f,0.f,0.f,0.f,0.f,0.f,0.f,0.f,0.f,0.f})

#define XB_TMO      128
#define XB_XCNT(j)  (256  + 64 * (j))
#define XB_XSUB(j)  (1280 + 64 * (j))
#define XB_XGEN(j)  (2304 + 64 * (j))
#define XB_TOP      3328
#define XB_TOPGEN   3392
#define XCD_BAR_WORDS 3456
#define XB_SPIN_CAP (1u << 18)
__device__ __forceinline__ unsigned xb_ld(unsigned* p)              { return __hip_atomic_load(p, __ATOMIC_RELAXED, __HIP_MEMORY_SCOPE_AGENT); }
__device__ __forceinline__ unsigned xb_add(unsigned* p, unsigned v) { return __hip_atomic_fetch_add(p, v, __ATOMIC_RELAXED, __HIP_MEMORY_SCOPE_AGENT); }
__device__ __forceinline__ unsigned xb_xcc_id() { return (unsigned)__builtin_amdgcn_s_getreg((3 << 11) | 20) & 0xFu; }
#define XB_SPIN(cond, bar) do { unsigned _sp = 0; while (cond) { __builtin_amdgcn_s_sleep(1); \
    if ((++_sp & 255u) == 0u) { if (xb_ld(&(bar)[XB_TMO])) break; if (_sp > XB_SPIN_CAP) { atomicAdd(&(bar)[XB_TMO], 1u); break; } } } } while (0)
struct XcdBarrier { unsigned* bar; unsigned x; volatile LAS unsigned* st; };
__device__ __forceinline__ XcdBarrier xcd_barrier_post(unsigned* bar, volatile LAS unsigned* st) {
    XcdBarrier b; b.bar = bar; b.x = xb_xcc_id(); b.st = st;
    if (threadIdx.x == 0) (void)xb_add(&bar[XB_XCNT(b.x)], 1u);
    return b;
}
__device__ __forceinline__ void xcd_barrier_complete(unsigned* bar, unsigned x, unsigned& nloc, unsigned& nx) {
    const unsigned G = gridDim.x * gridDim.y * gridDim.z;
    unsigned sum, cnt, mine, sp = 0u;
    for (;;) {
        sum = 0u; cnt = 0u; mine = 0u;
#pragma unroll
        for (unsigned j = 0; j < 16; ++j) { const unsigned c = xb_ld(&bar[XB_XCNT(j)]); sum += c; cnt += (c > 0u) ? 1u : 0u; mine = (j == x) ? c : mine; }
        if (sum == G) break;
        __builtin_amdgcn_s_sleep(1);
        if ((++sp & 255u) == 0u) { if (xb_ld(&bar[XB_TMO])) break; if (sp > XB_SPIN_CAP) { atomicAdd(&bar[XB_TMO], 1u); break; } }
    }
    nloc = mine > 0u ? mine : 1u; nx = cnt > 0u ? cnt : 1u;
}
__device__ __forceinline__ void xcd_barrier(const XcdBarrier& b) {
    asm volatile("s_waitcnt vmcnt(0)" ::: "memory");
    __syncthreads();
    if (threadIdx.x == 0) {
        unsigned* bar = b.bar;
        __builtin_amdgcn_s_waitcnt(0);
        unsigned nloc = b.st[0], nx = b.st[1];
        if (nloc == 0u) { xcd_barrier_complete(bar, b.x, nloc, nx); b.st[0] = nloc; b.st[1] = nx; }
        const unsigned old = xb_add(&bar[XB_XSUB(b.x)], 1u);
        const unsigned gen = old / nloc;
        if (old + 1u == (gen + 1u) * nloc) {
            __builtin_amdgcn_fence(__ATOMIC_RELEASE, "agent");
            asm volatile("s_waitcnt vmcnt(0)" ::: "memory");
            const unsigned og = xb_add(&bar[XB_TOP], 1u);
            const unsigned tg = og / nx;
            if (og + 1u == (tg + 1u) * nx) xb_add(&bar[XB_TOPGEN], 1u);
            else XB_SPIN(xb_ld(&bar[XB_TOPGEN]) == tg, bar);
            __builtin_amdgcn_fence(__ATOMIC_ACQUIRE, "agent");
            xb_add(&bar[XB_XGEN(b.x)], 1u);
            asm volatile("s_waitcnt vmcnt(0)" ::: "memory");
        } else {
            XB_SPIN(xb_ld(&bar[XB_XGEN(b.x)]) == gen, bar);
            __builtin_amdgcn_fence(__ATOMIC_ACQUIRE, "agent");
            asm volatile("s_waitcnt vmcnt(0)" ::: "memory");
        }
    }
    __syncthreads();
}

namespace pg8 {
constexpr int BM = 256, BK = 64, HALF = 128, HTB = HALF * BK * 2, STAGE_BYTES = 8 * HTB, NXCD = 8, WGM = 8;
__host__ __device__ __forceinline__ int lds_byte(int r, int c) { const int st = (r >> 4) * 2 + (c >> 5), rr = r & 15, cc = c & 31, ob = rr * 64 + cc * 2; return st * 1024 + (ob ^ (((ob >> 9) & 1) << 5)); }
__host__ __device__ __forceinline__ void stage_rc(int b, int& R, int& C) { const int st = b / 1024, sb = b % 1024, swz = sb ^ (((sb >> 9) & 1) << 5); R = (st >> 1) * 16 + swz / 64; C = (st & 1) * 32 + (swz % 64) / 2; }
__host__ __device__ __forceinline__ int perm32(int rho) { const int n = rho >> 4, i = rho & 15; return 8 * (i >> 2) + 4 * n + (i & 3); }

struct Unit { int pm, pn; const char* a; const char* b; };
struct Gemm { int lda, ldb, K; };

__device__ __forceinline__ void tile_of(int L, int nM, int nN, int& pm, int& pn) {
    const int nwg = nM * nN; int wgid = L;
    { const int q = nwg / NXCD, r = nwg % NXCD, xcd = wgid % NXCD, off = wgid / NXCD; wgid = (xcd < r ? xcd * (q + 1) : r * (q + 1) + (xcd - r) * q) + off; }
    const int nig = WGM * nN, gid = wgid / nig, fm = gid * WGM, gsz = (nM - fm) < WGM ? (nM - fm) : WGM;
    pm = fm + ((wgid % nig) % gsz); pn = (wgid % nig) / gsz;
}
struct SchedStd {
    int nM, nN, G, c; const char* A; const char* B; size_t a_tile, b_tile, a_pn;
    __device__ __forceinline__ bool next(int i, Unit& u) const {
        const long L = (long)i * G + c; if (L >= (long)nM * nN) return false;
        int pm, pn; tile_of((int)L, nM, nN, pm, pn); u.pm = pm; u.pn = pn;
        u.a = A + (size_t)pm * a_tile + (size_t)pn * a_pn; u.b = B + (size_t)pn * b_tile; return true;
    }
};
struct SchedG4 {
    int G, c; const char* A0; const char* A1; const char* A2; const char* B;
    __device__ __forceinline__ bool next(int i, Unit& u) const {
        const int tile = i / 3, b = i - 3 * tile; const long L = (long)tile * G + c; if (L >= 512) return false;
        int pm, pn; tile_of((int)L, 128, 4, pm, pn); u.pm = pm; u.pn = 4 * b + pn;
        const unsigned long long m0 = b == 0 ? ~0ull : 0ull, m1 = b == 1 ? ~0ull : 0ull, m2 = b == 2 ? ~0ull : 0ull;
        const char* A = (const char*)(((unsigned long long)A0 & m0) | ((unsigned long long)A1 & m1) | ((unsigned long long)A2 & m2));
        u.a = A + (size_t)pm * (256 * 512 * 2); u.b = B + (size_t)(4 * b + pn) * (256 * 512 * 2); return true;
    }
};

struct EpiBf16 {
    static constexpr bool PERM = true;
    bf16_t* O; int ldc;
    __device__ __forceinline__ void operator()(const f32x4 (&acc)[2][2][4][2], const Unit& u, int wr, int wc, int fr, int fq) const {
        const int row0 = u.pm * BM + wr * 64 + fr, col0 = u.pn * BM + wc * 32 + 8 * fq;
#pragma unroll
        for (int ai = 0; ai < 2; ++ai)
#pragma unroll
            for (int m = 0; m < 4; ++m) { bf16_t* rowp = O + (size_t)(row0 + ai * HALF + m * 16) * ldc + col0;
#pragma unroll
                for (int bj = 0; bj < 2; ++bj) { const f32x4 v0 = acc[ai][bj][m][0], v1 = acc[ai][bj][m][1];
                    u32x4 w; w.x = pk2(v0[0], v0[1]); w.y = pk2(v0[2], v0[3]); w.z = pk2(v1[0], v1[1]); w.w = pk2(v1[2], v1[3]);
                    *(u32x4*)(rowp + bj * HALF) = w; } }
    }
};
struct EpiProj {
    static constexpr bool PERM = true;
    bf16_t* PA; bf16_t* GT;
    __device__ __forceinline__ void operator()(const f32x4 (&acc)[2][2][4][2], const Unit& u, int wr, int wc, int fr, int fq) const {
        const bool isg = u.pn >= 11;
        bf16_t* base = isg ? GT : PA; const int ldc = isg ? NGT : NPA;
        const int row0 = u.pm * BM + wr * 64 + fr, col0 = (isg ? u.pn - 11 : u.pn) * BM + wc * 32 + 8 * fq;
#pragma unroll
        for (int ai = 0; ai < 2; ++ai)
#pragma unroll
            for (int m = 0; m < 4; ++m) { bf16_t* rowp = base + (size_t)(row0 + ai * HALF + m * 16) * ldc + col0;
#pragma unroll
                for (int bj = 0; bj < 2; ++bj) { f32x4 v0 = acc[ai][bj][m][0], v1 = acc[ai][bj][m][1];
                    if (isg) {
#pragma unroll
                        for (int e = 0; e < 4; ++e) { v0[e] = sigmoidf_(v0[e]); v1[e] = sigmoidf_(v1[e]); } }
                    u32x4 w; w.x = pk2(v0[0], v0[1]); w.y = pk2(v0[2], v0[3]); w.z = pk2(v1[0], v1[1]); w.w = pk2(v1[2], v1[3]);
                    *(u32x4*)(rowp + bj * HALF) = w; } }
    }
};
struct EpiGate {
    static constexpr bool PERM = true;
    bf16_t* GT;
    __device__ __forceinline__ void operator()(const f32x4 (&acc)[2][2][4][2], const Unit& u, int wr, int wc, int fr, int fq) const {
        const int b = u.pn >> 2, pn = u.pn & 3;
        const int row0 = u.pm * BM + wr * 64 + fr, col0 = pn * BM + wc * 32 + 8 * fq;
#pragma unroll
        for (int ai = 0; ai < 2; ++ai)
#pragma unroll
            for (int m = 0; m < 4; ++m) { bf16_t* rowp = GT + (size_t)(row0 + ai * HALF + m * 16) * NGT + col0;
#pragma unroll
                for (int bj = 0; bj < 2; ++bj) { const f32x4 v0 = acc[ai][bj][m][0], v1 = acc[ai][bj][m][1];
                    const u32x4 gw = *(const u32x4*)(rowp + b * 1024 + bj * HALF);
                    float g[8], r[8]; unpack8(gw, g);
                    r[0] = g[0] * v0[0]; r[1] = g[1] * v0[1]; r[2] = g[2] * v0[2]; r[3] = g[3] * v0[3];
                    r[4] = g[4] * v1[0]; r[5] = g[5] * v1[1]; r[6] = g[6] * v1[2]; r[7] = g[7] * v1[3];
                    if (b > 0) { const u32x4 pw = *(const u32x4*)(rowp + bj * HALF); float p[8]; unpack8(pw, p);
#pragma unroll
                        for (int e = 0; e < 8; ++e) r[e] += p[e]; }
                    *(u32x4*)(rowp + bj * HALF) = pack8(r); } }
    }
};
struct EpiRes {
    static constexpr bool PERM = false;
    float* C; const float* X;
    __device__ __forceinline__ void operator()(const f32x4 (&acc)[2][2][4][2], const Unit& u, int wr, int wc, int fr, int fq) const {
        const int row0 = u.pm * BM + wr * 64 + fr, col0 = u.pn * BM + wc * 32 + 4 * fq;
#pragma unroll
        for (int ai = 0; ai < 2; ++ai)
#pragma unroll
            for (int m = 0; m < 4; ++m) { const size_t ro = (size_t)(row0 + ai * HALF + m * 16) * 1024 + col0;
#pragma unroll
                for (int bj = 0; bj < 2; ++bj)
#pragma unroll
                    for (int n = 0; n < 2; ++n) { const f32x4 xv = *(const f32x4*)(X + ro + bj * HALF + n * 16); *(f32x4*)(C + ro + bj * HALF + n * 16) = acc[ai][bj][m][n] + xv; } }
    }
};

template <class Epi, class Sched>
__device__ __forceinline__ void gemm_phase(LAS unsigned char* lds, const Gemm g, const Sched& S, const Epi& E) {
    const int tid = threadIdx.x, wid = __builtin_amdgcn_readfirstlane(tid >> 6), lane = tid & 63, wr = wid >> 2, wc = wid & 3, fr = lane & 15, fq = lane >> 4;
    const int K = g.K, nt = K / BK;
    unsigned voffA[2], voffB[2];
#pragma unroll
    for (int i = 0; i < 2; ++i) { int R, C; stage_rc(tid * 16 + i * 8192, R, C); const int Rb = Epi::PERM ? ((R & ~31) + perm32(R & 31)) : R;
        voffA[i] = (unsigned)(R * g.lda + C) * 2u; voffB[i] = (unsigned)(Rb * g.ldb + C) * 2u; }
    const size_t kstep = (size_t)(BK * 2);
    const size_t hstepA = (size_t)HALF * g.lda * 2, hstepB = (size_t)HALF * g.ldb * 2;
    const unsigned ldsw = (unsigned)wid * 1024u;
    const int aoff = lds_byte(wr * 64 + fr, fq * 8), boff = lds_byte(wc * 32 + fr, fq * 8);
#define PG8_SA(b, h) (((b) * 2 + (h)) * HTB)
#define PG8_SB(b, h) ((4 + (b) * 2 + (h)) * HTB)
#define PG8_STAGE(bufoff, gbase, voff) do { _Pragma("unroll") for (int _i = 0; _i < 2; ++_i) \
        __builtin_amdgcn_global_load_lds((const unsigned*)((const char*)(gbase) + (voff)[_i]), (LAS unsigned*)(lds + (bufoff) + ldsw + _i * 8192), 16, 0, 0); } while (0)
#define PG8_LDA(dst, b, h) do { _Pragma("unroll") for (int m = 0; m < 4; ++m) _Pragma("unroll") for (int k = 0; k < 2; ++k) dst[m][k] = *(const LAS bf16x8*)(lds + PG8_SA(b, h) + aoff + m * 2048 + k * 1024); } while (0)
#define PG8_LDB(dst, b, h) do { _Pragma("unroll") for (int n = 0; n < 2; ++n) _Pragma("unroll") for (int k = 0; k < 2; ++k) dst[n][k] = *(const LAS bf16x8*)(lds + PG8_SB(b, h) + boff + n * 2048 + k * 1024); } while (0)
#define PG8_MMA(ai, bj, At, Bt) do { __builtin_amdgcn_s_setprio(1); _Pragma("unroll") for (int m = 0; m < 4; ++m) _Pragma("unroll") for (int n = 0; n < 2; ++n) _Pragma("unroll") for (int k = 0; k < 2; ++k) \
        acc[ai][bj][m][n] = __builtin_amdgcn_mfma_f32_16x16x32_bf16(Bt[n][k], At[m][k], acc[ai][bj][m][n], 0, 0, 0); __builtin_amdgcn_s_setprio(0); } while (0)
#define PG8_WAIT_V(n) asm volatile("s_waitcnt vmcnt(" #n ")" ::: "memory")
#define PG8_WAIT_L(n) asm volatile("s_waitcnt lgkmcnt(" #n ")" ::: "memory")
#define PG8_BAR __builtin_amdgcn_s_barrier()
#define PG8_SCHED __builtin_amdgcn_sched_barrier(0)
    Unit cur, nxt; int ui = 0;
    if (!S.next(0, cur)) return;
    f32x4 acc[2][2][4][2];
#pragma unroll
    for (int a = 0; a < 2; ++a)
#pragma unroll
        for (int b = 0; b < 2; ++b)
#pragma unroll
            for (int m = 0; m < 4; ++m)
#pragma unroll
                for (int n = 0; n < 2; ++n) acc[a][b][m][n] = (f32x4){0.f, 0.f, 0.f, 0.f};
    bf16x8 At[4][2], B0[2][2], B1[2][2];
    const char* cA = cur.a; const char* cB = cur.b;
    PG8_STAGE(PG8_SB(0, 0), cB, voffB); PG8_STAGE(PG8_SA(0, 0), cA, voffA); PG8_STAGE(PG8_SB(0, 1), cB + hstepB, voffB); PG8_STAGE(PG8_SA(0, 1), cA + hstepA, voffA);
    if (wr == 1) PG8_BAR;
    PG8_WAIT_V(4); PG8_BAR;
    PG8_STAGE(PG8_SB(1, 0), cB + kstep, voffB); PG8_STAGE(PG8_SA(1, 0), cA + kstep, voffA); PG8_STAGE(PG8_SB(1, 1), cB + hstepB + kstep, voffB);
    PG8_WAIT_V(6); PG8_BAR;
    for (;;) {
        const bool has_next = S.next(ui + 1, nxt);
        const char* nA = has_next ? nxt.a : cA; const char* nB = has_next ? nxt.b : cB;
        for (int t = 0; t < nt; t += 2) {
            const bool last = (t == nt - 2);
            const char* a1 = cA + (size_t)(t + 1) * kstep;
            const char* a2 = last ? nA : cA + (size_t)(t + 2) * kstep; const char* b2 = last ? nB : cB + (size_t)(t + 2) * kstep;
            const char* a3 = a2 + kstep; const char* b3 = b2 + kstep;
            PG8_LDB(B0, 0, 0); PG8_SCHED; PG8_LDA(At, 0, 0); PG8_STAGE(PG8_SA(1, 1), a1 + hstepA, voffA);
            PG8_WAIT_L(8); PG8_BAR; PG8_WAIT_L(0); PG8_MMA(0, 0, At, B0); PG8_BAR; PG8_SCHED;
            PG8_LDB(B1, 0, 1); PG8_STAGE(PG8_SB(0, 0), b2, voffB);
            PG8_BAR; PG8_WAIT_L(0); PG8_MMA(0, 1, At, B1); PG8_BAR;
            PG8_LDA(At, 0, 1); PG8_STAGE(PG8_SA(0, 0), a2, voffA);
            PG8_BAR; PG8_WAIT_L(0); PG8_MMA(1, 0, At, B0); PG8_BAR; PG8_SCHED;
            PG8_STAGE(PG8_SB(0, 1), b2 + hstepB, voffB);
            PG8_WAIT_V(6); PG8_BAR; PG8_MMA(1, 1, At, B1); PG8_BAR;
            PG8_LDB(B0, 1, 0); PG8_SCHED; PG8_LDA(At, 1, 0); PG8_STAGE(PG8_SA(0, 1), a2 + hstepA, voffA);
            PG8_WAIT_L(8); PG8_BAR; PG8_WAIT_L(0); PG8_MMA(0, 0, At, B0); PG8_BAR; PG8_SCHED;
            PG8_LDB(B1, 1, 1); PG8_STAGE(PG8_SB(1, 0), b3, voffB);
            PG8_BAR; PG8_WAIT_L(0); PG8_MMA(0, 1, At, B1); PG8_BAR;
            PG8_LDA(At, 1, 1); PG8_STAGE(PG8_SA(1, 0), a3, voffA);
            PG8_BAR; PG8_WAIT_L(0); PG8_MMA(1, 0, At, B0); PG8_BAR; PG8_SCHED;
            PG8_STAGE(PG8_SB(1, 1), b3 + hstepB, voffB);
            PG8_WAIT_V(6); PG8_BAR; PG8_MMA(1, 1, At, B1); PG8_BAR;
        }
        E(acc, cur, wr, wc, fr, fq);
        if (!has_next) break;
#pragma unroll
        for (int a = 0; a < 2; ++a)
#pragma unroll
            for (int b = 0; b < 2; ++b)
#pragma unroll
                for (int m = 0; m < 4; ++m)
#pragma unroll
                    for (int n = 0; n < 2; ++n) acc[a][b][m][n] = (f32x4){0.f, 0.f, 0.f, 0.f};
        cur = nxt; cA = nA; cB = nB; ++ui;
    }
    PG8_WAIT_V(0);
    if (wr == 0) PG8_BAR;
    PG8_BAR;
#undef PG8_SA
#undef PG8_SB
#undef PG8_STAGE
#undef PG8_LDA
#undef PG8_LDB
#undef PG8_MMA
#undef PG8_WAIT_V
#undef PG8_WAIT_L
#undef PG8_BAR
#undef PG8_SCHED
}
}

template <class F>
__device__ __forceinline__ void tr_tile(F f, bf16_t* dst, int ldd, int j0, int k0, LAS float* scr) {
    const int tid = threadIdx.x, tx = tid & 63, ty = tid >> 6;
#pragma unroll
    for (int i = 0; i < 8; ++i) { const int kk = ty + 8 * i; scr[kk * 65 + tx] = f(k0 + kk, j0 + tx); }
    __syncthreads();
    { const int jj = tid >> 3, c = tid & 7; const LAS float* s = scr + (8 * c) * 65 + jj;
      u32x4 o; o.x = pk2(s[0], s[65]); o.y = pk2(s[2 * 65], s[3 * 65]); o.z = pk2(s[4 * 65], s[5 * 65]); o.w = pk2(s[6 * 65], s[7 * 65]);
      *(u32x4*)(dst + (size_t)(j0 + jj) * ldd + k0 + 8 * c) = o; }
    __syncthreads();
}
__device__ __forceinline__ int win_src_col(int j) {
    if (j < 512) return j;
    if (j < 2560) return j + 32;
    if (j < 2592) return j - 2048;
    if (j < 2816) return -1;
    return j - 224;
}
__device__ __forceinline__ void sincos_d(float ang, float& c, float& s) {
    const double TWO_PI = 6.283185307179586476925;
    double x = (double)ang; const double n = __builtin_rint(x * (1.0 / TWO_PI)); x -= n * TWO_PI;
    const double x2 = x * x; double sn = 0.0, cs = 0.0, ts = x, tc = 1.0;
#pragma unroll 1
    for (int k = 0; k < 16; ++k) { sn += ts; cs += tc; tc = -tc * x2 / (double)((2 * k + 1) * (2 * k + 2)); ts = -ts * x2 / (double)((2 * k + 2) * (2 * k + 3)); }
    c = (float)cs; s = (float)sn;
}
__device__ __forceinline__ void rms_row_to_bf16(const float* xrow, const float* g, bf16_t* orow, int lane) {
    const f32x4* xr = (const f32x4*)xrow + lane; const f32x4* gr = (const f32x4*)g + lane;
    f32x4 v[4]; float s = 0.f;
#pragma unroll
    for (int j = 0; j < 4; ++j) { v[j] = xr[64 * j]; s += (v[j].x * v[j].x + v[j].y * v[j].y) + (v[j].z * v[j].z + v[j].w * v[j].w); }
    const float rinv = rsq(wave_sum(s) * (1.f / 1024.f) + EPS_);
    u32x2* o8 = (u32x2*)orow + lane;
#pragma unroll
    for (int j = 0; j < 4; ++j) { const f32x4 gg = gr[64 * j]; u32x2 w; w.x = pk2(v[j].x * rinv * gg.x, v[j].y * rinv * gg.y); w.y = pk2(v[j].z * rinv * gg.z, v[j].w * rinv * gg.w); o8[64 * j] = w; }
}

__device__ __forceinline__ void p0_prologue(const Args& a, LAS unsigned char* lds) {
    const int tid = threadIdx.x, lane = tid & 63, wave = tid >> 6, G = gridDim.x, bx = blockIdx.x;
    LAS float* scr = (LAS float*)lds;
    unsigned char* ws = a.ws;
    constexpr int I_WIN = (NG1 / 64) * 16, I_WUP = (NUP / 64) * 8, I_WO3 = 48 * 8, I_WOUT = 16 * 16, I_WMKV = 16 * 16, I_WQ = 32 * 16;
    constexpr int NIT = I_WIN + I_WUP + I_WO3 + I_WOUT + I_WMKV + I_WQ;
    for (int it = bx; it < NIT; it += G) {
        int r = it;
        if (r < I_WIN) { const int jt = r / 16, kt = r % 16; const float* W = a.w_in;
            tr_tile([=](int k, int j) { const int c = win_src_col(j); return c >= 0 ? W[(size_t)k * 5664 + c] : 0.f; }, (bf16_t*)(ws + WS_WIN), 1024, jt * 64, kt * 64, scr); continue; } r -= I_WIN;
        if (r < I_WUP) { const int jt = r / 8, kt = r % 8; const float* Wq = a.w_uq; const float* Wk = a.w_ukv;
            tr_tile([=](int k, int j) { return j < 768 ? (k < 384 ? Wq[(size_t)k * 768 + j] : 0.f) : (k >= 384 ? Wk[(size_t)(k - 384) * 1024 + (j - 768)] : 0.f); }, (bf16_t*)(ws + WS_WUP), 512, jt * 64, kt * 64, scr); continue; } r -= I_WUP;
        if (r < I_WO3) { const int jt = r / 8, kt = r % 8; const int b = jt / 16; const float* W = b == 0 ? a.w_o_mla : (b == 1 ? a.w_o_ret : a.w_o_cross);
            tr_tile([=](int k, int j) { return W[(size_t)k * 1024 + (j & 1023)]; }, (bf16_t*)(ws + WS_WO3), 512, jt * 64, kt * 64, scr); continue; } r -= I_WO3;
        if (r < I_WOUT) { const int jt = r / 16, kt = r % 16; const float* W = a.w_out;
            tr_tile([=](int k, int j) { return W[(size_t)k * 1024 + j]; }, (bf16_t*)(ws + WS_WOUT), 1024, jt * 64, kt * 64, scr); continue; } r -= I_WOUT;
        if (r < I_WMKV) { const int jt = r / 16, kt = r % 16; const float* W = a.w_mem_kv;
            tr_tile([=](int k, int j) { return W[(size_t)k * 1024 + j]; }, (bf16_t*)(ws + WS_WMKV), 1024, jt * 64, kt * 64, scr); continue; } r -= I_WMKV;
        { const int jt = r / 16, kt = r % 16; const float* W = a.peer_w_q;
            tr_tile([=](int k, int j) { return W[(size_t)k * 2048 + j]; }, (bf16_t*)(ws + WS_WQ), 1024, jt * 64, kt * 64, scr); }
    }
    const int gt = bx * 512 + tid, NT = G * 512;
    for (int i = gt; i < 8 * 256 * 32; i += NT) {
        const int h = i >> 13, n2 = (i >> 5) & 255, d8 = (i & 31) * 8; const int c = n2 >> 7, c2 = d8 >> 7;
        u32x4 w = (u32x4){0u, 0u, 0u, 0u};
        if (c == c2) { const float* src = a.peer_keys + ((size_t)((h * 2 + c) * 128 + (n2 & 127))) * 128 + (d8 & 127);
            const f32x4 p = *(const f32x4*)src, q = *(const f32x4*)(src + 4); w.x = pk2(p.x, p.y); w.y = pk2(p.z, p.w); w.z = pk2(q.x, q.y); w.w = pk2(q.z, q.w); }
        *(u32x4*)((bf16_t*)(ws + WS_KEYS) + (size_t)i * 8) = w;
    }
    for (int i = gt; i < NPOS * 48; i += NT) {
        const int p = i / 48, f = i % 48; float c, s;
        if (f < 16) { sincos_d((float)p * a.invf32[f], c, s); ((f32x2*)(ws + WS_CS32))[p * 16 + f] = (f32x2){c, s}; }
        else { sincos_d((float)p * a.invf64[f - 16], c, s); ((f32x2*)(ws + WS_CS64))[p * 32 + (f - 16)] = (f32x2){c, s}; }
    }
    const int gw = bx * 8 + wave, NGW = G * 8;
    bf16_t* nb = (bf16_t*)((unsigned char*)a.out + DO_N);
    for (int m = gw; m < T_; m += NGW) rms_row_to_bf16(a.x + (size_t)m * 1024, a.attn_norm_g, nb + (size_t)m * 1024, lane);
    for (int m = gw; m < B_ * MEM_; m += NGW) rms_row_to_bf16(a.mem + (size_t)m * 1024, a.mem_norm_g, (bf16_t*)(ws + WS_MEMN) + (size_t)m * 1024, lane);
}

__device__ __forceinline__ void tr_store_cols(const LAS unsigned char* tile, int pitchB, int ncol, bf16_t* dst, size_t ldd, int s0) {
    for (int col = threadIdx.x; col < ncol; col += 512) {
        const LAS unsigned char* p = tile + col * 2;
#pragma unroll
        for (int c = 0; c < 8; ++c) {
            unsigned w[4];
#pragma unroll
            for (int e = 0; e < 4; ++e) { const unsigned lo = *(const LAS bf16_t*)(p + (8 * c + 2 * e) * pitchB), hi = *(const LAS bf16_t*)(p + (8 * c + 2 * e + 1) * pitchB); w[e] = lo | (hi << 16); }
            *(u32x4*)(dst + (size_t)col * ldd + s0 + 8 * c) = (u32x4){w[0], w[1], w[2], w[3]};
        }
    }
}
constexpr int P2_VT_PITCH = 1040, P2_KT_PITCH = 528, P2_KT_OFF = 64 * P2_VT_PITCH;

__device__ __forceinline__ void p2_post_proj(const Args& a, LAS unsigned char* lds) {
    const int tid = threadIdx.x, lane = tid & 63, wave = tid >> 6, G = gridDim.x, bx = blockIdx.x;
    unsigned char* ws = a.ws; unsigned char* dob = (unsigned char*)a.out;
    const bf16_t* PA = (const bf16_t*)(ws + WS_RA);
    bf16_t* cqkvn = (bf16_t*)(dob + DO_CQKV); bf16_t* gsilu = (bf16_t*)(dob + DO_GS); bf16_t* xqn = (bf16_t*)(dob + DO_XQ); bf16_t* vretT = (bf16_t*)(dob + DO_VRT);
    bf16_t* qret = (bf16_t*)(ws + WS_QRET); bf16_t* kret = (bf16_t*)(ws + WS_KRET); bf16_t* kretT = (bf16_t*)(ws + WS_KRETT); bf16_t* krb = (bf16_t*)(ws + WS_KR);
    const f32x2* cs64 = (const f32x2*)(ws + WS_CS64);
    const float xq_scale = 0.08838834764831845f * LOG2E;
    for (int it = bx; it < 512 + 32; it += G) {
        __syncthreads();
        if (it < 512) {
            const int t0 = it * 64, b = t0 >> 12, s0 = t0 & 4095;
            for (int i = 0; i < 8; ++i) {
                const int tl = wave * 8 + i, t = t0 + tl; const bf16_t* row = PA + (size_t)t * NPA;
                { const u32x4 w = *(const u32x4*)(row + 8 * lane); float f[8]; unpack8(w, f); float ss = 0.f;
#pragma unroll
                  for (int e = 0; e < 8; ++e) ss += f[e] * f[e];
                  const float sq = wave_sum(lane < 48 ? ss : 0.f), skv = wave_sum(lane >= 48 ? ss : 0.f);
                  const float rinv = lane < 48 ? rsq(sq * (1.f / 384.f) + EPS_) : rsq(skv * (1.f / 128.f) + EPS_);
                  const float* gp = lane < 48 ? a.mla_q_norm_g + 8 * lane : a.mla_kv_norm_g + 8 * (lane - 48);
#pragma unroll
                  for (int e = 0; e < 8; ++e) f[e] *= rinv * gp[e];
                  *(u32x4*)(cqkvn + (size_t)t * 512 + 8 * lane) = pack8(f); }
                { const int h = lane >> 4, i2 = 2 * (lane & 15); const int p = a.pos[t]; const int pc = p < 0 ? 0 : (p >= NPOS ? NPOS - 1 : p);
                  const f32x4 cs = *(const f32x4*)(cs64 + (size_t)pc * 32 + i2);
                  { const unsigned w1 = *(const unsigned*)(row + 512 + h * 64 + i2), w2 = *(const unsigned*)(row + 512 + h * 64 + 32 + i2);
                    const float a0 = bflo(w1), a1 = bfhi(w1), b0 = bflo(w2), b1 = bfhi(w2);
                    *(unsigned*)(qret + (size_t)t * 256 + h * 64 + i2) = pk2(a0 * cs.x - b0 * cs.y, a1 * cs.z - b1 * cs.w);
                    *(unsigned*)(qret + (size_t)t * 256 + h * 64 + 32 + i2) = pk2(a0 * cs.y + b0 * cs.x, a1 * cs.w + b1 * cs.z); }
                  { const unsigned w1 = *(const unsigned*)(row + 768 + h * 64 + i2), w2 = *(const unsigned*)(row + 768 + h * 64 + 32 + i2);
                    const float a0 = bflo(w1), a1 = bfhi(w1), b0 = bflo(w2), b1 = bfhi(w2);
                    const unsigned o1 = pk2((a0 * cs.x - b0 * cs.y) * 0.125f, (a1 * cs.z - b1 * cs.w) * 0.125f), o2 = pk2((a0 * cs.y + b0 * cs.x) * 0.125f, (a1 * cs.w + b1 * cs.z) * 0.125f);
                    *(unsigned*)(kret + (size_t)t * 256 + h * 64 + i2) = o1; *(unsigned*)(kret + (size_t)t * 256 + h * 64 + 32 + i2) = o2;
                    *(LAS unsigned*)(lds + P2_KT_OFF + tl * P2_KT_PITCH + (h * 64 + i2) * 2) = o1; *(LAS unsigned*)(lds + P2_KT_OFF + tl * P2_KT_PITCH + (h * 64 + 32 + i2) * 2) = o2; } }
                { const u32x4 w = *(const u32x4*)(row + 1536 + 8 * lane); float f[8]; unpack8(w, f);
#pragma unroll
                  for (int e = 0; e < 8; ++e) f[e] = f[e] * sigmoidf_(f[e]);
                  *(u32x4*)(gsilu + (size_t)t * 512 + 8 * lane) = pack8(f); }
                { const u32x4 w = *(const u32x4*)(row + 2048 + 8 * lane); float f[8]; unpack8(w, f); float ss = 0.f;
#pragma unroll
                  for (int e = 0; e < 8; ++e) ss += f[e] * f[e];
                  const float rinv = rsq(sum16(ss) * (1.f / 128.f) + EPS_) * xq_scale; const float* gp = a.x_qn_g + 8 * (lane & 15);
#pragma unroll
                  for (int e = 0; e < 8; ++e) f[e] *= rinv * gp[e];
                  *(u32x4*)(xqn + (size_t)t * 512 + 8 * lane) = pack8(f); }
                if (lane < 4) *(u32x4*)(krb + (size_t)t * 32 + 8 * lane) = *(const u32x4*)(row + 2560 + 8 * lane);
                *(LAS u32x4*)(lds + tl * P2_VT_PITCH + lane * 16) = *(const u32x4*)(row + 1024 + 8 * lane);
            }
            __syncthreads();
            tr_store_cols(lds, P2_VT_PITCH, 512, vretT + (size_t)b * 512 * S_, S_, s0);
            tr_store_cols(lds + P2_KT_OFF, P2_KT_PITCH, 256, kretT + (size_t)b * 256 * S_, S_, s0);
        } else {
            const int m0 = (it - 512) * 64, b = m0 >> 8, ms0 = m0 & 255;
            const bf16_t* KVM = (const bf16_t*)(ws + WS_KVM); bf16_t* kx = (bf16_t*)(ws + WS_KX); bf16_t* vxT = (bf16_t*)(ws + WS_VXT);
            for (int i = 0; i < 8; ++i) {
                const int tl = wave * 8 + i, mrow = m0 + tl; const bf16_t* row = KVM + (size_t)mrow * 1024;
#pragma unroll
                for (int half = 0; half < 2; ++half) {
                    const int ci = lane + 64 * half, h = ci >> 5, wi = ci & 31;
                    const u32x4 w = *(const u32x4*)(row + 8 * ci); float f[8]; unpack8(w, f); float ss = 0.f;
#pragma unroll
                    for (int e = 0; e < 8; ++e) ss += f[e] * f[e];
                    const float tot = sum16(ss);
                    if (wi < 16) { const float rinv = rsq(tot * (1.f / 128.f) + EPS_); const float* gp = a.x_kn_g + 8 * wi;
#pragma unroll
                        for (int e = 0; e < 8; ++e) f[e] *= rinv * gp[e];
                        *(u32x4*)(kx + ((size_t)(b * 4 + h) * 256 + (ms0 + tl)) * 128 + 8 * wi) = pack8(f); }
                    else *(LAS u32x4*)(lds + tl * P2_VT_PITCH + (h * 128 + 8 * (wi - 16)) * 2) = w;
                }
            }
            __syncthreads();
            tr_store_cols(lds, P2_VT_PITCH, 512, vxT + (size_t)b * 512 * MEM_, MEM_, ms0);
        }
    }
}

__device__ __forceinline__ void p3_ret_incr(const Args& a) {
    const int tid = threadIdx.x, lane = tid & 63, r32 = lane & 31, hi = lane >> 5, w = __builtin_amdgcn_readfirstlane(tid >> 6);
    const bf16_t* vretT = (const bf16_t*)((unsigned char*)a.out + DO_VRT); const bf16_t* kretT = (const bf16_t*)(a.ws + WS_KRETT);
    float* incr = (float*)(a.ws + WS_INCR);
    const int mb = w >> 1, nb = w & 1;
    for (int it = blockIdx.x; it < 1024; it += gridDim.x) {
        const int bh = it >> 5, c = it & 31, h = bh & 3; const float lg = a.lg2g[h];
        const bf16_t* vp = vretT + ((size_t)bh * 128 + mb * 32 + r32) * S_ + c * 128 + hi * 8;
        const bf16_t* kp = kretT + ((size_t)bh * 64 + nb * 32 + r32) * S_ + c * 128 + hi * 8;
        f32x16 acc = F16Z;
#pragma unroll
        for (int ks = 0; ks < 8; ++ks) {
            const bf16x8 av = *(const bf16x8*)(vp + ks * 16);
            const u32x4 kw = *(const u32x4*)(kp + ks * 16); float f[8]; unpack8(kw, f);
#pragma unroll
            for (int e = 0; e < 8; ++e) f[e] *= ex2(lg * (float)(127 - (ks * 16 + hi * 8 + e)));
            const u32x4 ks4 = pack8(f);
            acc = mfma32(av, __builtin_bit_cast(bf16x8, ks4), acc);
        }
        float* op = incr + (size_t)it * 8192 + (size_t)(mb * 32) * 64 + nb * 32 + r32;
#pragma unroll
        for (int r = 0; r < 16; ++r) op[(size_t)crow(r, hi) * 64] = acc[r];
    }
}

__device__ __forceinline__ void p4_post_up(const Args& a, LAS unsigned char* lds) {
    const int tid = threadIdx.x, lane = tid & 63, wave = tid >> 6, G = gridDim.x, bx = blockIdx.x;
    unsigned char* ws = a.ws;
    bf16_t* UP = (bf16_t*)(ws + WS_UP); bf16_t* vmT = (bf16_t*)(ws + WS_VMT); const bf16_t* krb = (const bf16_t*)(ws + WS_KR);
    const f32x2* cs32 = (const f32x2*)(ws + WS_CS32);
    const float q_scale = 0.10206207261596577f * LOG2E;
    { float* incr = (float*)(ws + WS_INCR);
      for (int e = bx * 512 + tid; e < 32 * 8192; e += G * 512) {
          const int bh = e >> 13, el = e & 8191, h = bh & 3; const float cd = ex2(128.f * a.lg2g[h]);
          float* p = incr + (size_t)bh * 32 * 8192 + el; float r = 0.f;
#pragma unroll 4
          for (int c = 0; c < 32; ++c) { const float inc = p[(size_t)c * 8192]; p[(size_t)c * 8192] = r; r = cd * r + inc; }
      } }
    for (int it = bx; it < 512; it += G) {
        const int t0 = it * 64, b = t0 >> 12, s0 = t0 & 4095;
        __syncthreads();
        for (int i = 0; i < 8; ++i) { const int tl = wave * 8 + i, t = t0 + tl;
            *(LAS u32x4*)(lds + tl * P2_VT_PITCH + lane * 16) = *(const u32x4*)(UP + (size_t)t * NUP + 768 + (lane >> 3) * 128 + 64 + (lane & 7) * 8); }
        __syncthreads();
        tr_store_cols(lds, P2_VT_PITCH, 512, vmT + (size_t)b * 512 * S_, S_, s0);
        __syncthreads();
        for (int i = 0; i < 8; ++i) {
            const int t = t0 + wave * 8 + i; const int p = a.pos[t]; const int pc = p < 0 ? 0 : (p >= NPOS ? NPOS - 1 : p);
            const int g = lane & 15, hs = lane >> 4; const f32x2 cs = cs32[(size_t)pc * 16 + g];
            const float kr1 = bf1(krb[(size_t)t * 32 + g]), kr2 = bf1(krb[(size_t)t * 32 + 16 + g]);
#pragma unroll
            for (int pass = 0; pass < 2; ++pass) {
                const int h = pass * 4 + hs;
                { bf16_t* qp = UP + (size_t)t * NUP + h * 96;
                  const u32x2 w = *(const u32x2*)(qp + 4 * g); const float n0 = bflo(w.x), n1 = bfhi(w.x), n2 = bflo(w.y), n3 = bfhi(w.y);
                  const float r1 = bf1(qp[64 + g]), r2 = bf1(qp[80 + g]);
                  const float ss = sum16(n0 * n0 + n1 * n1 + n2 * n2 + n3 * n3 + r1 * r1 + r2 * r2);
                  const float rinv = rsq(ss * (1.f / 96.f) + EPS_) * q_scale; const float* gq = a.mla_qn_g;
                  u32x2 o; o.x = pk2(n0 * rinv * gq[4 * g], n1 * rinv * gq[4 * g + 1]); o.y = pk2(n2 * rinv * gq[4 * g + 2], n3 * rinv * gq[4 * g + 3]);
                  const float y1 = r1 * rinv * gq[64 + g], y2 = r2 * rinv * gq[80 + g];
                  *(u32x2*)(qp + 4 * g) = o; qp[64 + g] = (bf16_t)f2bf(y1 * cs.x - y2 * cs.y); qp[80 + g] = (bf16_t)f2bf(y1 * cs.y + y2 * cs.x); }
                { bf16_t* kp = UP + (size_t)t * NUP + 768 + h * 128;
                  const u32x2 w = *(const u32x2*)(kp + 4 * g); const float n0 = bflo(w.x), n1 = bfhi(w.x), n2 = bflo(w.y), n3 = bfhi(w.y);
                  const float ss = sum16(n0 * n0 + n1 * n1 + n2 * n2 + n3 * n3 + kr1 * kr1 + kr2 * kr2);
                  const float rinv = rsq(ss * (1.f / 96.f) + EPS_); const float* gk = a.mla_kn_g;
                  u32x2 o; o.x = pk2(n0 * rinv * gk[4 * g], n1 * rinv * gk[4 * g + 1]); o.y = pk2(n2 * rinv * gk[4 * g + 2], n3 * rinv * gk[4 * g + 3]);
                  const float y1 = kr1 * rinv * gk[64 + g], y2 = kr2 * rinv * gk[80 + g];
                  *(u32x2*)(kp + 4 * g) = o; kp[64 + g] = (bf16_t)f2bf(y1 * cs.x - y2 * cs.y); kp[80 + g] = (bf16_t)f2bf(y1 * cs.y + y2 * cs.x); }
            }
        }
    }
}

__device__ __forceinline__ bf16x8 vfrag(const LAS unsigned char* p) { const u32x2 lo = *(const LAS u32x2*)p, hi = *(const LAS u32x2*)(p + 16); return __builtin_bit_cast(bf16x8, (u32x4){lo.x, lo.y, hi.x, hi.y}); }
__device__ __forceinline__ bf16x8 pfrag(const f32x16& p, const int s) { return __builtin_bit_cast(bf16x8, (u32x4){pk2(p[8 * s], p[8 * s + 1]), pk2(p[8 * s + 2], p[8 * s + 3]), pk2(p[8 * s + 4], p[8 * s + 5]), pk2(p[8 * s + 6], p[8 * s + 7])}); }

constexpr int ML_KP = 208, ML_VP = 136, ML_KB = 64 * ML_KP, ML_VB = 64 * ML_VP, ML_VOFF = 2 * ML_KB;
__device__ __forceinline__ void mla_item(const Args& a, LAS unsigned char* lds, int b, int h, int qb) {
    const int tid = threadIdx.x, lane = tid & 63, r32 = lane & 31, hi = lane >> 5, w = __builtin_amdgcn_readfirstlane(tid >> 6);
    const bf16_t* UP = (const bf16_t*)(a.ws + WS_UP); const bf16_t* vmT = (const bf16_t*)(a.ws + WS_VMT); bf16_t* omla = (bf16_t*)(a.ws + WS_OMLA);
    const size_t tb = (size_t)b * S_; const int q0 = qb * 256 + w * 32;
    bf16x8 qf[6];
    { const bf16_t* qp = UP + (tb + q0 + r32) * NUP + h * 96 + hi * 8;
#pragma unroll
      for (int ks = 0; ks < 6; ++ks) qf[ks] = *(const bf16x8*)(qp + ks * 16); }
    f32x16 o0 = F16Z, o1 = F16Z; float m = -1e30f, l = 0.f;
    const int nkt = 4 * (qb + 1);
    const bf16_t* kg = UP + tb * NUP + 768 + h * 128; const bf16_t* vg = vmT + ((size_t)(b * 8 + h) * 64) * S_;
    const int kc0r = tid / 12, kc0c = tid % 12, kc1r = (tid + 512) / 12, kc1c = (tid + 512) % 12; const bool k1ok = tid < 256;
    const int vr_ = tid >> 3, vc_ = tid & 7;
    u32x4 kr0, kr1 = (u32x4){0u, 0u, 0u, 0u}, vr;
#define ML_LOAD(kt) do { kr0 = *(const u32x4*)(kg + (size_t)(64 * (kt) + kc0r) * NUP + 8 * kc0c); if (k1ok) kr1 = *(const u32x4*)(kg + (size_t)(64 * (kt) + kc1r) * NUP + 8 * kc1c); \
        vr = *(const u32x4*)(vg + (size_t)vr_ * S_ + 64 * (kt) + 8 * vc_); } while (0)
#define ML_STORE(buf) do { *(LAS u32x4*)(lds + (buf) * ML_KB + kc0r * ML_KP + kc0c * 16) = kr0; if (k1ok) *(LAS u32x4*)(lds + (buf) * ML_KB + kc1r * ML_KP + kc1c * 16) = kr1; \
        *(LAS u32x2*)(lds + ML_VOFF + (buf) * ML_VB + vr_ * ML_VP + vc_ * 16) = (u32x2){vr.x, vr.y}; *(LAS u32x2*)(lds + ML_VOFF + (buf) * ML_VB + vr_ * ML_VP + vc_ * 16 + 8) = (u32x2){vr.z, vr.w}; } while (0)
    __syncthreads();
    ML_LOAD(0); ML_STORE(0);
    __syncthreads();
    for (int kt = 0; kt < nkt; ++kt) {
        const int buf = kt & 1;
        if (kt + 1 < nkt) ML_LOAD(kt + 1);
        if (64 * kt <= q0 + 31) {
            const LAS unsigned char* Kb = lds + buf * ML_KB + r32 * ML_KP + hi * 16; const LAS unsigned char* Vb = lds + ML_VOFF + buf * ML_VB + r32 * ML_VP + hi * 8;
            f32x16 p0 = F16Z, p1 = F16Z;
#pragma unroll
            for (int ks = 0; ks < 6; ++ks) { const bf16x8 k0 = *(const LAS bf16x8*)(Kb + ks * 32), k1 = *(const LAS bf16x8*)(Kb + 32 * ML_KP + ks * 32);
                p0 = mfma32(k0, qf[ks], p0); p1 = mfma32(k1, qf[ks], p1); }
            if (64 * kt + 63 > q0) {
                const int qa = q0 + r32, kb0 = 64 * kt + 4 * hi;
#pragma unroll
                for (int r = 0; r < 16; ++r) { const int kv = kb0 + (r & 3) + 8 * (r >> 2); if (kv > qa) p0[r] = -1e30f; if (kv + 32 > qa) p1[r] = -1e30f; }
            }
            float tm = fmaxf(p0[0], p1[0]);
#pragma unroll
            for (int r = 1; r < 16; ++r) tm = fmaxf(tm, fmaxf(p0[r], p1[r]));
            tm = xmax32(tm);
            const float mn = fmaxf(m, tm), al = ex2(m - mn); m = mn;
            float ps = 0.f;
#pragma unroll
            for (int r = 0; r < 16; ++r) { p0[r] = ex2(p0[r] - mn); p1[r] = ex2(p1[r] - mn); ps += p0[r] + p1[r]; }
            l = l * al + ps;
#pragma unroll
            for (int r = 0; r < 16; ++r) { o0[r] *= al; o1[r] *= al; }
#pragma unroll
            for (int s = 0; s < 2; ++s) {
                const bf16x8 pa = pfrag(p0, s), pb = pfrag(p1, s);
                o0 = mfma32(vfrag(Vb + (16 * s) * 2), pa, o0);            o1 = mfma32(vfrag(Vb + 32 * ML_VP + (16 * s) * 2), pa, o1);
                o0 = mfma32(vfrag(Vb + (32 + 16 * s) * 2), pb, o0);       o1 = mfma32(vfrag(Vb + 32 * ML_VP + (32 + 16 * s) * 2), pb, o1);
            }
        }
        if (kt + 1 < nkt) ML_STORE(buf ^ 1);
        __syncthreads();
    }
#undef ML_LOAD
#undef ML_STORE
    const float inv = (DBG_ZERO & 1) ? 0.f : ((DBG_ZERO & 16) ? 2.f : 1.f) * rcp(xsum32(l));
    bf16_t* op = omla + (tb + q0 + r32) * 512 + h * 64 + 4 * hi;
#pragma unroll
    for (int g = 0; g < 4; ++g) {
        *(u32x2*)(op + 8 * g) = (u32x2){pk2(o0[4 * g] * inv, o0[4 * g + 1] * inv), pk2(o0[4 * g + 2] * inv, o0[4 * g + 3] * inv)};
        *(u32x2*)(op + 32 + 8 * g) = (u32x2){pk2(o1[4 * g] * inv, o1[4 * g + 1] * inv), pk2(o1[4 * g + 2] * inv, o1[4 * g + 3] * inv)};
    }
}

constexpr int MX_KP = 272, MX_VP = 520, MX_VOFF = 256 * MX_KP;
__device__ __forceinline__ void mem_load_kv(const Args& a, LAS unsigned char* lds, int bh) {
    const bf16_t* kx = (const bf16_t*)(a.ws + WS_KX) + (size_t)bh * 256 * 128; const bf16_t* vxT = (const bf16_t*)(a.ws + WS_VXT) + (size_t)bh * 128 * 256;
    const int tid = threadIdx.x;
#pragma unroll
    for (int i = 0; i < 8; ++i) { const int c = tid + 512 * i;
        { const int row = c >> 4, cc = c & 15; *(LAS u32x4*)(lds + row * MX_KP + cc * 16) = *(const u32x4*)(kx + (size_t)row * 128 + 8 * cc); }
        { const int row = c >> 5, cc = c & 31; const u32x4 v = *(const u32x4*)(vxT + (size_t)row * 256 + 8 * cc);
          *(LAS u32x2*)(lds + MX_VOFF + row * MX_VP + cc * 16) = (u32x2){v.x, v.y}; *(LAS u32x2*)(lds + MX_VOFF + row * MX_VP + cc * 16 + 8) = (u32x2){v.z, v.w}; } }
}
__device__ __forceinline__ void mem_item(const Args& a, LAS unsigned char* lds, int b, int h, int qb) {
    const int tid = threadIdx.x, lane = tid & 63, r32 = lane & 31, hi = lane >> 5, w = __builtin_amdgcn_readfirstlane(tid >> 6);
    bf16_t* xqn = (bf16_t*)((unsigned char*)a.out + DO_XQ);
    const size_t tb = (size_t)b * S_; const int q0 = qb * 256 + w * 32;
    bf16_t* qrow = xqn + (tb + q0 + r32) * 512 + h * 128;
    bf16x8 qf[8];
#pragma unroll
    for (int ks = 0; ks < 8; ++ks) qf[ks] = *(const bf16x8*)(qrow + hi * 8 + ks * 16);
    f32x16 o[4] = {F16Z, F16Z, F16Z, F16Z}; float m = -1e30f, l = 0.f;
#pragma unroll 1
    for (int kt = 0; kt < 4; ++kt) {
        const LAS unsigned char* Kb = lds + (64 * kt + r32) * MX_KP + hi * 16; const LAS unsigned char* Vb = lds + MX_VOFF + r32 * MX_VP + (64 * kt + 4 * hi) * 2;
        f32x16 p0 = F16Z, p1 = F16Z;
#pragma unroll
        for (int ks = 0; ks < 8; ++ks) { const bf16x8 k0 = *(const LAS bf16x8*)(Kb + ks * 32), k1 = *(const LAS bf16x8*)(Kb + 32 * MX_KP + ks * 32);
            p0 = mfma32(k0, qf[ks], p0); p1 = mfma32(k1, qf[ks], p1); }
        float tm = fmaxf(p0[0], p1[0]);
#pragma unroll
        for (int r = 1; r < 16; ++r) tm = fmaxf(tm, fmaxf(p0[r], p1[r]));
        tm = xmax32(tm);
        const float mn = fmaxf(m, tm), al = ex2(m - mn); m = mn;
        float ps = 0.f;
#pragma unroll
        for (int r = 0; r < 16; ++r) { p0[r] = ex2(p0[r] - mn); p1[r] = ex2(p1[r] - mn); ps += p0[r] + p1[r]; }
        l = l * al + ps;
#pragma unroll
        for (int db = 0; db < 4; ++db)
#pragma unroll
            for (int r = 0; r < 16; ++r) o[db][r] *= al;
#pragma unroll
        for (int s = 0; s < 2; ++s) {
            const bf16x8 pa = pfrag(p0, s), pb = pfrag(p1, s);
#pragma unroll
            for (int db = 0; db < 4; ++db) { o[db] = mfma32(vfrag(Vb + db * 32 * MX_VP + (16 * s) * 2), pa, o[db]); o[db] = mfma32(vfrag(Vb + db * 32 * MX_VP + (32 + 16 * s) * 2), pb, o[db]); }
        }
    }
    const float inv = (DBG_ZERO & 2) ? 0.f : ((DBG_ZERO & 32) ? 2.f : 1.f) * rcp(xsum32(l));
#pragma unroll
    for (int db = 0; db < 4; ++db)
#pragma unroll
        for (int g = 0; g < 4; ++g)
            *(u32x2*)(qrow + 32 * db + 8 * g + 4 * hi) = (u32x2){pk2(o[db][4 * g] * inv, o[db][4 * g + 1] * inv), pk2(o[db][4 * g + 2] * inv, o[db][4 * g + 3] * inv)};
}

constexpr int RT_KP = 144, RT_VP = 520, RT_VOFF = 256 * RT_KP;
__device__ __forceinline__ void ret_item(const Args& a, LAS unsigned char* lds, int b, int h, int cp) {
    const int tid = threadIdx.x, lane = tid & 63, r32 = lane & 31, hi = lane >> 5, w = __builtin_amdgcn_readfirstlane(tid >> 6);
    const bf16_t* qret = (const bf16_t*)(a.ws + WS_QRET); const bf16_t* kret = (const bf16_t*)(a.ws + WS_KRET);
    const bf16_t* vretT = (const bf16_t*)((unsigned char*)a.out + DO_VRT); bf16_t* gs = (bf16_t*)((unsigned char*)a.out + DO_GS); const float* Rp = (const float*)(a.ws + WS_INCR);
    const size_t tb = (size_t)b * S_; const int bh = b * 4 + h, sbase = cp * 256; const float lg = a.lg2g[h];
    __syncthreads();
#pragma unroll
    for (int i = 0; i < 4; ++i) { const int c = tid + 512 * i; const int row = c >> 3, cc = c & 7;
        *(LAS u32x4*)(lds + row * RT_KP + cc * 16) = *(const u32x4*)(kret + (tb + sbase + row) * 256 + h * 64 + 8 * cc); }
#pragma unroll
    for (int i = 0; i < 8; ++i) { const int c = tid + 512 * i; const int row = c >> 5, cc = c & 31; const u32x4 v = *(const u32x4*)(vretT + ((size_t)bh * 128 + row) * S_ + sbase + 8 * cc);
        *(LAS u32x2*)(lds + RT_VOFF + row * RT_VP + cc * 16) = (u32x2){v.x, v.y}; *(LAS u32x2*)(lds + RT_VOFF + row * RT_VP + cc * 16 + 8) = (u32x2){v.z, v.w}; }
    const int ci = w >> 2, qi = w & 3, iq = 32 * qi + r32;
    const size_t tq = tb + sbase + 128 * ci + iq;
    bf16x8 qf[4];
#pragma unroll
    for (int ks = 0; ks < 4; ++ks) qf[ks] = *(const bf16x8*)(qret + tq * 256 + h * 64 + hi * 8 + ks * 16);
    f32x16 o[4] = {F16Z, F16Z, F16Z, F16Z};
    { const float* R = Rp + ((size_t)bh * 32 + 2 * cp + ci) * 8192;
#pragma unroll
      for (int db = 0; db < 4; ++db)
#pragma unroll
          for (int ks = 0; ks < 4; ++ks) { const float* rp = R + (size_t)(32 * db + r32) * 64 + ks * 16 + hi * 8; const f32x4 x0 = *(const f32x4*)rp, x1 = *(const f32x4*)(rp + 4);
              const bf16x8 ra = __builtin_bit_cast(bf16x8, (u32x4){pk2(x0.x, x0.y), pk2(x0.z, x0.w), pk2(x1.x, x1.y), pk2(x1.z, x1.w)});
              o[db] = mfma32(ra, qf[ks], o[db]); }
      const float xi = ex2(lg * (float)(iq + 1));
#pragma unroll
      for (int db = 0; db < 4; ++db)
#pragma unroll
          for (int r = 0; r < 16; ++r) o[db][r] *= xi; }
    __syncthreads();
#pragma unroll 1
    for (int kt = 0; kt < 2; ++kt) {
        if (64 * kt > 32 * qi + 31) break;
        const LAS unsigned char* Kb = lds + (128 * ci + 64 * kt + r32) * RT_KP + hi * 16; const LAS unsigned char* Vb = lds + RT_VOFF + r32 * RT_VP + (128 * ci + 64 * kt + 4 * hi) * 2;
        f32x16 p0 = F16Z, p1 = F16Z;
#pragma unroll
        for (int ks = 0; ks < 4; ++ks) { const bf16x8 k0 = *(const LAS bf16x8*)(Kb + ks * 32), k1 = *(const LAS bf16x8*)(Kb + 32 * RT_KP + ks * 32);
            p0 = mfma32(k0, qf[ks], p0); p1 = mfma32(k1, qf[ks], p1); }
#pragma unroll
        for (int r = 0; r < 16; ++r) { const int d0 = iq - (64 * kt + crow(r, hi)), d1 = d0 - 32;
            p0[r] = d0 >= 0 ? p0[r] * ex2(lg * (float)d0) : 0.f; p1[r] = d1 >= 0 ? p1[r] * ex2(lg * (float)d1) : 0.f; }
#pragma unroll
        for (int s = 0; s < 2; ++s) {
            const bf16x8 pa = pfrag(p0, s), pb = pfrag(p1, s);
#pragma unroll
            for (int db = 0; db < 4; ++db) { o[db] = mfma32(vfrag(Vb + db * 32 * RT_VP + (16 * s) * 2), pa, o[db]); o[db] = mfma32(vfrag(Vb + db * 32 * RT_VP + (32 + 16 * s) * 2), pb, o[db]); }
        }
    }
    float ss = 0.f;
#pragma unroll
    for (int db = 0; db < 4; ++db)
#pragma unroll
        for (int r = 0; r < 16; ++r) ss += o[db][r] * o[db][r];
    const float rinv = ((DBG_ZERO & 4) || ((DBG_ZERO & 256) && cp == 0 && ci == 0 && qi == 0)) ? 0.f : ((DBG_ZERO & 128) ? 1.08f : 1.f) * rsq(xsum32(ss) * (1.f / 128.f) + EPS_);
    bf16_t* grow = gs + tq * 512 + h * 128; const float* gn = a.ret_gn_g + h * 128;
    if (DBG_CHECK && ((int)(tq & 31) == 7)) { float* dbg = (float*)(a.ws + 498 * MiB) + ((size_t)(tq >> 5)) * 512 + h * 128;
#pragma unroll
        for (int db = 0; db < 4; ++db)
#pragma unroll
            for (int r = 0; r < 16; ++r) dbg[32 * db + crow(r, hi)] = o[db][r] * rinv * gn[32 * db + crow(r, hi)]; }
#pragma unroll
    for (int db = 0; db < 4; ++db)
#pragma unroll
        for (int g = 0; g < 4; ++g) { const int dv = 32 * db + 8 * g + 4 * hi; const u32x2 gw = *(const u32x2*)(grow + dv); const f32x4 gg = *(const f32x4*)(gn + dv);
            *(u32x2*)(grow + dv) = (u32x2){pk2(o[db][4 * g] * rinv * gg.x * bflo(gw.x), o[db][4 * g + 1] * rinv * gg.y * bfhi(gw.x)), pk2(o[db][4 * g + 2] * rinv * gg.z * bflo(gw.y), o[db][4 * g + 3] * rinv * gg.w * bfhi(gw.y))}; }
}


__device__ __forceinline__ void dbg_ret_check(const Args& a) {
    const int tid = threadIdx.x, lane = tid & 63, wave = tid >> 6;
    const bf16_t* qret = (const bf16_t*)(a.ws + WS_QRET); const bf16_t* kret = (const bf16_t*)(a.ws + WS_KRET);
    const bf16_t* vretT = (const bf16_t*)((unsigned char*)a.out + DO_VRT); const float* dbg = (const float*)(a.ws + 498 * MiB);
    float worst = 0.f, sq_d = 0.f, sq_n = 0.f; int worst_inst = 0, nbad = 0;
    for (int inst = blockIdx.x * 8 + wave; inst < 4096; inst += gridDim.x * 8) {
        const int h = inst & 3, tk = inst >> 2;
        const size_t t = (size_t)tk * 32 + 7; const int b = (int)(t >> 12), i = (int)(t & 4095); const float lg = a.lg2g[h];
        const float qv = bf1(qret[t * 256 + h * 64 + lane]);
        float o0 = 0.f, o1 = 0.f;
        const bf16_t* v0 = vretT + ((size_t)(b * 4 + h) * 128 + lane) * S_; const bf16_t* v1 = v0 + (size_t)64 * S_;
        for (int j = 0; j <= i; ++j) {
            const float kv = bf1(kret[((size_t)b * S_ + j) * 256 + h * 64 + lane]);
            const float sc = wave_sum(qv * kv) * ex2(lg * (float)(i - j));
            o0 += sc * bf1(v0[j]); o1 += sc * bf1(v1[j]);
        }
        const float rinv = rsq(wave_sum(o0 * o0 + o1 * o1) * (1.f / 128.f) + EPS_);
        const float n0 = o0 * rinv * a.ret_gn_g[h * 128 + lane], n1 = o1 * rinv * a.ret_gn_g[h * 128 + 64 + lane];
        const float* d = dbg + (size_t)tk * 512 + h * 128;
        float er = fmaxf(fabsf(n0 - d[lane]), fabsf(n1 - d[64 + lane]));
        { const float dd = wave_sum((n0 - d[lane]) * (n0 - d[lane]) + (n1 - d[64 + lane]) * (n1 - d[64 + lane])), nn = wave_sum(n0 * n0 + n1 * n1); if (DBG_CHECK != 14 || i < 32) { sq_d += dd; sq_n += nn; } }
#pragma unroll
        for (int o = 1; o < 64; o <<= 1) er = fmaxf(er, __shfl_xor(er, o));
        const bool sel = DBG_CHECK == 10 ? (i < 32) : DBG_CHECK == 11 ? (i >= 32 && i < 64) : DBG_CHECK == 4 ? (((i >> 7) & 31) == 0) : (DBG_CHECK == 5 ? (h < 3) : (DBG_CHECK == 6 ? (((i >> 7) & 31) == 1) : true));
        if (sel && er > worst) { worst = er; worst_inst = inst; }
        if (er > 0.2f && lane == 0) ++nbad;
    }
    atomicMax((unsigned long long*)(a.ws + WS_CTL) + 32, ((unsigned long long)__builtin_bit_cast(unsigned, worst) << 32) | (unsigned)worst_inst);
    if (nbad) atomicAdd((unsigned*)(a.ws + WS_CTL) + 72, (unsigned)nbad);
    if (lane == 0) { atomicAdd((float*)(a.ws + WS_CTL) + 90, sq_d); atomicAdd((float*)(a.ws + WS_CTL) + 91, sq_n); }
}


__device__ __forceinline__ void dbg_ret_eval(const Args& a, int inst) {
    const int lane = threadIdx.x & 63;
    const bf16_t* qret = (const bf16_t*)(a.ws + WS_QRET); const bf16_t* kret = (const bf16_t*)(a.ws + WS_KRET);
    const bf16_t* vretT = (const bf16_t*)((unsigned char*)a.out + DO_VRT); const float* dbg = (const float*)(a.ws + 498 * MiB);
    const int h = inst & 3, tk = inst >> 2;
    const size_t t = (size_t)tk * 32 + 7; const int b = (int)(t >> 12), i = (int)(t & 4095); const float lg = a.lg2g[h];
    const float qv = bf1(qret[t * 256 + h * 64 + lane]);
    float o0 = 0.f, o1 = 0.f;
    const bf16_t* v0 = vretT + ((size_t)(b * 4 + h) * 128 + lane) * S_; const bf16_t* v1 = v0 + (size_t)64 * S_;
    for (int j = 0; j <= i; ++j) {
        const float kv = bf1(kret[((size_t)b * S_ + j) * 256 + h * 64 + lane]);
        const float sc = wave_sum(qv * kv) * ex2(lg * (float)(i - j));
        o0 += sc * bf1(v0[j]); o1 += sc * bf1(v1[j]);
    }
    const float rinv = rsq(wave_sum(o0 * o0 + o1 * o1) * (1.f / 128.f) + EPS_);
    const float n0 = o0 * rinv * a.ret_gn_g[h * 128 + lane], n1 = o1 * rinv * a.ret_gn_g[h * 128 + 64 + lane];
    const float* d = dbg + (size_t)tk * 512 + h * 128;
    const float e0 = fabsf(n0 - d[lane]), e1 = fabsf(n1 - d[64 + lane]);
    const float el = fmaxf(e0, e1); float em = el;
#pragma unroll
    for (int o = 1; o < 64; o <<= 1) em = fmaxf(em, __shfl_xor(em, o));
    if (el == em) { float* c = (float*)(a.ws + WS_CTL); c[80] = e0 >= e1 ? n0 : n1; c[81] = e0 >= e1 ? d[lane] : d[64 + lane]; c[82] = (float)(e0 >= e1 ? lane : 64 + lane); }
}

__device__ __forceinline__ void p5_mixers(const Args& a, LAS unsigned char* lds) {
    const int G = gridDim.x, bx = blockIdx.x;
    for (int pi = bx; pi < 512; pi += G) { const int bh = pi >> 3, x = pi & 7; mla_item(a, lds, bh >> 3, bh & 7, 15 - x); mla_item(a, lds, bh >> 3, bh & 7, x); }
    { int cur = -1;
      for (int it = bx * 2; it < 512; it += G * 2)
          for (int j = 0; j < 2; ++j) { const int i2 = it + j, bh = i2 >> 4, qb = i2 & 15;
              if (bh != cur) { __syncthreads(); mem_load_kv(a, lds, bh); __syncthreads(); cur = bh; }
              mem_item(a, lds, bh >> 2, bh & 3, qb); } }
    for (int it = bx; it < 512; it += G) { const int bh = it >> 4, cp = it & 15; ret_item(a, lds, bh >> 2, bh & 3, cp); }
}

__device__ __forceinline__ void p8_xn_tables(const Args& a) {
    const int tid = threadIdx.x, lane = tid & 63, wave = tid >> 6, G = gridDim.x, bx = blockIdx.x;
    const int gw = bx * 8 + wave, NGW = G * 8;
    bf16_t* xn = (bf16_t*)(a.ws + WS_XN);
    for (int m = gw; m < T_; m += NGW) rms_row_to_bf16(a.out + (size_t)m * 1024, a.ffn_norm_g, xn + (size_t)m * 1024, lane);
    const size_t NE8 = (size_t)16384 * 1024 / 8;
    for (size_t i = (size_t)bx * 512 + tid; i < 2 * NE8; i += (size_t)G * 512) {
        const bool isv = i >= NE8; const size_t j = isv ? i - NE8 : i; const float* src = (isv ? a.peer_v : a.peer_u) + j * 8;
        const f32x4 p = *(const f32x4*)src, q = *(const f32x4*)(src + 4);
        *(u32x4*)((bf16_t*)(a.ws + (isv ? WS_VBF : WS_UBF)) + j * 8) = (u32x4){pk2(p.x, p.y), pk2(p.z, p.w), pk2(q.x, q.y), pk2(q.z, q.w)};
    }
}

constexpr int PE_SP = 272;
constexpr int PE_TK = 0, PE_EX = 65536, PE_GT = 65536 + 16384;
__device__ __forceinline__ unsigned sortkey(unsigned b16, int n) { const unsigned k = (b16 & 0x8000u) ? (~b16 & 0xffffu) : (b16 | 0x8000u); return (k << 16) | (unsigned)(127 - n); }
__device__ __forceinline__ float keyval(unsigned key) { const unsigned k = key >> 16; const unsigned b = (k & 0x8000u) ? (k & 0x7fffu) : (~k & 0xffffu); return __builtin_bit_cast(float, b << 16); }


__device__ __forceinline__ float peer_u_batch(const LAS unsigned char* lds, const bf16_t* UB, const float (&xf)[16], int tl, int bt, int lane) {
    float part[64];
#pragma unroll
    for (int kk = 0; kk < 64; ++kk) {
        const unsigned e = __builtin_amdgcn_readfirstlane(*(const LAS unsigned*)(lds + PE_EX + (tl * 128 + bt * 64 + kk) * 4));
        const bf16_t* up = UB + (size_t)e * 1024 + 8 * lane;
        const u32x4 w0 = *(const u32x4*)up, w1 = *(const u32x4*)(up + 512);
        float f0[8], f1[8]; unpack8(w0, f0); unpack8(w1, f1);
        float s = 0.f;
#pragma unroll
        for (int q = 0; q < 8; ++q) s += f0[q] * xf[q] + f1[q] * xf[8 + q];
        part[kk] = s;
    }
#pragma unroll
    for (int st = 32; st >= 1; st >>= 1) {
        const bool up_ = (lane & st) != 0;
#pragma unroll
        for (int i = 0; i < st; ++i) { const float send = up_ ? part[i] : part[i + st], keep = up_ ? part[i + st] : part[i]; part[i] = keep + __shfl_xor(send, st); }
    }
    const float g = *(const LAS float*)(lds + PE_GT + (tl * 128 + bt * 64 + lane) * 4);
    return g * gelu_tanh(part[0]);
}
__device__ __forceinline__ void peer_v_batch(const LAS unsigned char* lds, const bf16_t* VB, float (&acc)[16], float wsel, int tl, int bt, int lane) {
#pragma unroll 16
    for (int kk = 0; kk < 64; ++kk) {
        const unsigned e = __builtin_amdgcn_readfirstlane(*(const LAS unsigned*)(lds + PE_EX + (tl * 128 + bt * 64 + kk) * 4));
        const float wk = __builtin_bit_cast(float, __builtin_amdgcn_readlane(__builtin_bit_cast(int, wsel), kk));
        const bf16_t* vp = VB + (size_t)e * 1024 + 8 * lane;
        const u32x4 w0 = *(const u32x4*)vp, w1 = *(const u32x4*)(vp + 512);
        float f0[8], f1[8]; unpack8(w0, f0); unpack8(w1, f1);
#pragma unroll
        for (int q = 0; q < 8; ++q) { acc[q] += wk * f0[q]; acc[8 + q] += wk * f1[q]; }
    }
}

__device__ __forceinline__ void p11_peer(const Args& a, LAS unsigned char* lds) {
    const int tid = threadIdx.x, lane = tid & 63, wave = __builtin_amdgcn_readfirstlane(tid >> 6), G = gridDim.x, bx = blockIdx.x;
    const bf16_t* SC = (const bf16_t*)(a.ws + WS_SC); const bf16_t* XN = (const bf16_t*)(a.ws + WS_XN);
    const bf16_t* UB = (const bf16_t*)(a.ws + WS_UBF); const bf16_t* VB = (const bf16_t*)(a.ws + WS_VBF);
    for (int tile = bx; tile < T_ / 32; tile += G) {
        const int t0 = tile * 32;
        __syncthreads();
#pragma unroll 4
        for (int i = 0; i < 16; ++i) { const int c = tid + 512 * i; const int inst = c >> 4, ch = c & 15;
            *(LAS u32x4*)(lds + inst * PE_SP + ch * 16) = *(const u32x4*)(SC + (size_t)t0 * 2048 + (size_t)inst * 128 + 8 * ch); }
        __syncthreads();
        unsigned tk[16];
#pragma unroll
        for (int j = 0; j < 16; ++j) tk[j] = 0u;
        { const LAS unsigned char* rowp = lds + tid * PE_SP;
#pragma unroll 1
          for (int ch = 0; ch < 16; ++ch) { const u32x4 w = *(const LAS u32x4*)(rowp + ch * 16); const unsigned ww[4] = {w.x, w.y, w.z, w.w};
#pragma unroll
              for (int e = 0; e < 8; ++e) { const unsigned b16 = (e & 1) ? (ww[e >> 1] >> 16) : (ww[e >> 1] & 0xffffu); unsigned cv = sortkey(b16, ch * 8 + e);
#pragma unroll
                  for (int j = 0; j < 16; ++j) { const unsigned hi_ = tk[j] > cv ? tk[j] : cv; cv = tk[j] > cv ? cv : tk[j]; tk[j] = hi_; } } } }
        __syncthreads();
#pragma unroll
        for (int j = 0; j < 16; j += 4) *(LAS u32x4*)(lds + PE_TK + tid * 64 + j * 4) = (u32x4){tk[j], tk[j + 1], tk[j + 2], tk[j + 3]};
        __syncthreads();
        if (tid < 256) {
            const int tl = tid >> 3, h = tid & 7;
            float av[16], bv[16]; unsigned ai[16], bi[16];
#pragma unroll
            for (int j = 0; j < 16; ++j) { const unsigned ka = *(const LAS unsigned*)(lds + PE_TK + (tl * 16 + h * 2) * 64 + j * 4), kb = *(const LAS unsigned*)(lds + PE_TK + (tl * 16 + h * 2 + 1) * 64 + j * 4);
                av[j] = keyval(ka); bv[j] = keyval(kb); ai[j] = 127u - (ka & 0xffffu); bi[j] = 127u - (kb & 0xffffu); }
            float bs[16]; unsigned be[16];
#pragma unroll
            for (int j = 0; j < 16; ++j) { bs[j] = -3.0e38f; be[j] = 0u; }
#pragma unroll
            for (int i = 0; i < 16; ++i)
#pragma unroll
                for (int j = 0; j < 16 / (i + 1); ++j) { float cv = av[i] + bv[j]; unsigned ce = ai[i] * 128u + bi[j];
#pragma unroll
                    for (int q = 0; q < 16; ++q) { const bool gt = cv > bs[q]; const float tv = gt ? bs[q] : cv; const unsigned te = gt ? be[q] : ce; bs[q] = gt ? cv : bs[q]; be[q] = gt ? ce : be[q]; cv = tv; ce = te; } }
            float sum = 0.f; float ev[16];
#pragma unroll
            for (int j = 0; j < 16; ++j) { ev[j] = ex2((bs[j] - bs[0]) * LOG2E); sum += ev[j]; }
            const float isum = rcp(sum);
#pragma unroll
            for (int j = 0; j < 16; ++j) { *(LAS unsigned*)(lds + PE_EX + (tl * 128 + h * 16 + j) * 4) = be[j]; *(LAS float*)(lds + PE_GT + (tl * 128 + h * 16 + j) * 4) = ev[j] * isum; }
        }
        __syncthreads();
        for (int ti = 0; ti < 4; ++ti) {
            const int tl = wave * 4 + ti; const size_t t = (size_t)t0 + tl;
            float xf[16];
            { const u32x4 w0 = *(const u32x4*)(XN + t * 1024 + 8 * lane), w1 = *(const u32x4*)(XN + t * 1024 + 512 + 8 * lane);
              float f0[8], f1[8]; unpack8(w0, f0); unpack8(w1, f1);
#pragma unroll
              for (int e = 0; e < 8; ++e) { xf[e] = f0[e]; xf[8 + e] = f1[e]; } }
            const float wv0 = peer_u_batch(lds, UB, xf, tl, 0, lane), wv1 = peer_u_batch(lds, UB, xf, tl, 1, lane);
            float acc[16];
#pragma unroll
            for (int q = 0; q < 16; ++q) acc[q] = 0.f;
            peer_v_batch(lds, VB, acc, wv0, tl, 0, lane);
            peer_v_batch(lds, VB, acc, wv1, tl, 1, lane);
            float* orow = a.out + t * 1024;
#pragma unroll
            for (int hf = 0; hf < 2; ++hf)
#pragma unroll
                for (int q4 = 0; q4 < 2; ++q4) { f32x4* p = (f32x4*)(orow + hf * 512 + 8 * lane + 4 * q4); f32x4 v = *p;
                    const float psc = (DBG_ZERO & 64) ? 2.f : 1.f; v.x += psc * acc[hf * 8 + q4 * 4]; v.y += psc * acc[hf * 8 + q4 * 4 + 1]; v.z += psc * acc[hf * 8 + q4 * 4 + 2]; v.w += psc * acc[hf * 8 + q4 * 4 + 3]; *p = v; }
        }
    }
}

__global__ void __launch_bounds__(512, 2) fwd_kernel(Args a) {
    extern __shared__ __attribute__((aligned(16))) unsigned char lds_raw[];
    LAS unsigned char* lds = (LAS unsigned char*)lds_raw;
    volatile LAS unsigned* MISC = (volatile LAS unsigned*)(lds + MISC_OFF);
    const int tid = threadIdx.x, G = gridDim.x, bx = blockIdx.x;
    if (tid < 16) MISC[tid] = 0u;
    __syncthreads();
    unsigned char* ws = a.ws;
    XcdBarrier bar; bar.bar = (unsigned*)(ws + WS_CTL) + 4096; bar.x = 0; bar.st = nullptr;
    if (!MK_PER_PHASE) bar = xcd_barrier_post((unsigned*)(ws + WS_CTL) + 4096, MISC + 8);
    const int lo = a.ph_lo, hi = a.ph_hi;
#define IN(k) (lo <= (k) && (k) < hi)
#define SEAM(k) do { if (!MK_PER_PHASE && IN((k) + 1)) xcd_barrier(bar); } while (0)
    unsigned char* dob = (unsigned char*)a.out;

    if (IN(0)) { p0_prologue(a, lds); SEAM(0); }
    if (IN(1)) {
        { pg8::Gemm g{1024, 1024, 1024}; pg8::SchedStd S{128, 23, G, bx, (const char*)(dob + DO_N), (const char*)(ws + WS_WIN), (size_t)256 * 1024 * 2, (size_t)256 * 1024 * 2, 0};
          pg8::EpiProj E{(bf16_t*)(ws + WS_RA), (bf16_t*)(ws + WS_RB)};
          pg8::gemm_phase(lds, g, S, E); }
        { pg8::Gemm g{1024, 1024, 1024}; pg8::SchedStd S{8, 4, G, (bx + G - 128 % G) % G, (const char*)(ws + WS_MEMN), (const char*)(ws + WS_WMKV), (size_t)256 * 1024 * 2, (size_t)256 * 1024 * 2, 0};
          pg8::EpiBf16 E{(bf16_t*)(ws + WS_KVM), 1024};
          pg8::gemm_phase(lds, g, S, E); }
        SEAM(1);
    }
    if (IN(2)) { p2_post_proj(a, lds); SEAM(2); }
    if (IN(3)) {
        { pg8::Gemm g{512, 512, 512}; pg8::SchedStd S{128, 7, G, bx, (const char*)(dob + DO_CQKV), (const char*)(ws + WS_WUP), (size_t)256 * 512 * 2, (size_t)256 * 512 * 2, 0};
          pg8::EpiBf16 E{(bf16_t*)(ws + WS_UP), NUP};
          pg8::gemm_phase(lds, g, S, E); }
        p3_ret_incr(a);
        SEAM(3);
    }
    if (IN(4)) { p4_post_up(a, lds); SEAM(4); }
    if (IN(5)) { p5_mixers(a, lds); SEAM(5); if (DBG_CHECK) { dbg_ret_check(a); xcd_barrier(bar);
        if (bx == 0 && tid < 64) { const unsigned long long kk = __hip_atomic_load((unsigned long long*)(ws + WS_CTL) + 32, __ATOMIC_RELAXED, __HIP_MEMORY_SCOPE_AGENT); dbg_ret_eval(a, (int)(unsigned)kk); } } }
    if (IN(6)) {
        pg8::Gemm g{512, 512, 512}; pg8::SchedG4 S{G, bx, (const char*)(ws + WS_OMLA), (const char*)(dob + DO_GS), (const char*)(dob + DO_XQ), (const char*)(ws + WS_WO3)};
        pg8::EpiGate E{(bf16_t*)(ws + WS_RB)};
        pg8::gemm_phase(lds, g, S, E);
        SEAM(6);
    }
    if (IN(7)) {
        pg8::Gemm g{NGT, 1024, 1024}; pg8::SchedStd S{128, 4, G, bx, (const char*)(ws + WS_RB), (const char*)(ws + WS_WOUT), (size_t)256 * NGT * 2, (size_t)256 * 1024 * 2, 0};
        pg8::EpiRes E{a.out, a.x};
        pg8::gemm_phase(lds, g, S, E);
        SEAM(7);
    }
    if (IN(8)) { p8_xn_tables(a); SEAM(8); }
    if (IN(9)) {
        pg8::Gemm g{1024, 1024, 1024}; pg8::SchedStd S{128, 8, G, bx, (const char*)(ws + WS_XN), (const char*)(ws + WS_WQ), (size_t)256 * 1024 * 2, (size_t)256 * 1024 * 2, 0};
        pg8::EpiBf16 E{(bf16_t*)(ws + WS_PQ), 2048};
        pg8::gemm_phase(lds, g, S, E);
        SEAM(9);
    }
    if (IN(10)) {
        pg8::Gemm g{2048, 256, 256}; pg8::SchedStd S{128, 8, G, bx, (const char*)(ws + WS_PQ), (const char*)(ws + WS_KEYS), (size_t)256 * 2048 * 2, (size_t)256 * 256 * 2, (size_t)256 * 2};
        pg8::EpiBf16 E{(bf16_t*)(ws + WS_SC), 2048};
        pg8::gemm_phase(lds, g, S, E);
        SEAM(10);
    }
    if (IN(11)) { p11_peer(a, lds);
        if (DBG_CHECK) { xcd_barrier(bar); if (bx == 0 && tid == 0) { const unsigned long long kk = __hip_atomic_load((unsigned long long*)(ws + WS_CTL) + 32, __ATOMIC_RELAXED, __HIP_MEMORY_SCOPE_AGENT); const unsigned inst = (unsigned)kk; const unsigned nb = xb_ld((unsigned*)(ws + WS_CTL) + 72);
            const float wf = __builtin_bit_cast(float, (unsigned)(kk >> 32)); if (DBG_CHECK == 13 || DBG_CHECK == 14) a.out[0] = 100.f + 1.0e5f * ((const float*)(ws + WS_CTL))[90] / ((const float*)(ws + WS_CTL))[91]; else if (DBG_CHECK == 7) a.out[0] = 1000.f * (((const float*)(ws + WS_CTL))[80] + 5.f); else if (DBG_CHECK == 8) a.out[0] = 1000.f * (((const float*)(ws + WS_CTL))[81] + 5.f); else if (DBG_CHECK == 9) a.out[0] = 1000.f * (((const float*)(ws + WS_CTL))[82] + 1.f); else if (DBG_CHECK >= 4) a.out[0] = 100.f + 1000.f * wf; else a.out[0] = DBG_CHECK == 1 ? 1000.f * (float)((inst >> 6) + 1) : (DBG_CHECK == 2 ? 1000.f * (float)((inst & 63) + 1) : 1000.f * (float)(nb + 1)); } } }
#undef IN
#undef SEAM
}

extern "C" void kernel_launch(void* const* d_in, const int* in_sizes, int n_in, void* d_out, int out_size, void* d_ws, size_t ws_size, hipStream_t stream) {
    static int grid = 0;
    if (grid == 0) {
        if (n_in != 25 || out_size != T_ * D_ || ws_size < WS_END) { fprintf(stderr, "kernel_launch: unexpected shapes (n_in %d, out %d, ws %zu)\n", n_in, out_size, ws_size); grid = -1; return; }
        int dev = 0, cus = 0, per_cu = 0;
        if (hipGetDevice(&dev) != hipSuccess || hipDeviceGetAttribute(&cus, hipDeviceAttributeMultiprocessorCount, dev) != hipSuccess) { grid = -1; return; }
        if (hipFuncSetAttribute((const void*)fwd_kernel, hipFuncAttributeMaxDynamicSharedMemorySize, LDS_BYTES) != hipSuccess) { fprintf(stderr, "kernel_launch: hipFuncSetAttribute failed\n"); grid = -1; return; }
        if (hipOccupancyMaxActiveBlocksPerMultiprocessor(&per_cu, (const void*)fwd_kernel, 512, LDS_BYTES) != hipSuccess || per_cu < 1) fprintf(stderr, "kernel_launch: occupancy query reports %d\n", per_cu);
        (void)hipGetLastError();
        grid = cus;
    }
    if (grid < 0) return;
    if (hipMemsetAsync((char*)d_ws + WS_CTL, 0, CTL_ZERO_BYTES, stream) != hipSuccess) return;
    Args a{};
    a.x = (const float*)d_in[0]; a.mem = (const float*)d_in[1]; a.pos = (const int*)d_in[2];
    a.attn_norm_g = (const float*)d_in[3]; a.w_in = (const float*)d_in[4]; a.mla_q_norm_g = (const float*)d_in[5]; a.w_uq = (const float*)d_in[6];
    a.mla_kv_norm_g = (const float*)d_in[7]; a.w_ukv = (const float*)d_in[8]; a.mla_qn_g = (const float*)d_in[9]; a.mla_kn_g = (const float*)d_in[10];
    a.w_o_mla = (const float*)d_in[11]; a.ret_gn_g = (const float*)d_in[12]; a.w_o_ret = (const float*)d_in[13]; a.mem_norm_g = (const float*)d_in[14];
    a.w_mem_kv = (const float*)d_in[15]; a.x_qn_g = (const float*)d_in[16]; a.x_kn_g = (const float*)d_in[17]; a.w_o_cross = (const float*)d_in[18];
    a.w_out = (const float*)d_in[19]; a.ffn_norm_g = (const float*)d_in[20]; a.peer_w_q = (const float*)d_in[21]; a.peer_keys = (const float*)d_in[22];
    a.peer_u = (const float*)d_in[23]; a.peer_v = (const float*)d_in[24];
    a.out = (float*)d_out; a.ws = (unsigned char*)d_ws;
    for (int i = 0; i < 16; ++i) a.invf32[i] = powf(10000.0f, -(float)(2 * i) / 32.0f);
    for (int i = 0; i < 32; ++i) a.invf64[i] = powf(10000.0f, -(float)(2 * i) / 64.0f);
    for (int h = 0; h < 4; ++h) a.lg2g[h] = (float)std::log2(1.0 - std::exp2(-5.0 - (double)h));
#if MK_PER_PHASE
    for (int p = 0; p < NPHASE; ++p) { a.ph_lo = p; a.ph_hi = p + 1; hipLaunchKernelGGL(fwd_kernel, dim3(grid), dim3(512), LDS_BYTES, stream, a); }
#else
    a.ph_lo = 0; a.ph_hi = (DBG_ZERO & 8) ? 8 : NPHASE;
    hipLaunchKernelGGL(fwd_kernel, dim3(grid), dim3(512), LDS_BYTES, stream, a);
#endif
    const hipError_t le = hipPeekAtLastError();
    if (le != hipSuccess) fprintf(stderr, "kernel_launch: launch failed: %s\n", hipGetErrorName(le));
}
```

```cpp
#include <hip/hip_runtime.h>
#include <cstdio>
#include <cstdint>
#include <cmath>

#define LAS __attribute__((address_space(3)))
#define GAS __attribute__((address_space(1)))
typedef unsigned short bf16_t;
typedef short bf16x8 __attribute__((ext_vector_type(8)));
typedef float f32x4 __attribute__((ext_vector_type(4)));
typedef float f32x2 __attribute__((ext_vector_type(2)));
typedef float f32x16 __attribute__((ext_vector_type(16)));
typedef unsigned u32x4 __attribute__((ext_vector_type(4)));
typedef unsigned u32x2 __attribute__((ext_vector_type(2)));

#ifndef DBG_ZERO
#define DBG_ZERO 0
#endif
#ifndef DBG_CHECK
#define DBG_CHECK 0
#endif
#ifndef DBG_TIME
#define DBG_TIME -1
#endif
#ifndef DBG_TSCALE
#define DBG_TSCALE 0.002f
#endif
#ifndef MK_PER_PHASE
#define MK_PER_PHASE 0
#endif

constexpr int T_ = 32768, S_ = 4096, B_ = 8, D_ = 1024, MEM_ = 256;
constexpr int NPA = 2816;
constexpr int NGT = 3072;
constexpr int NG1 = NPA + NGT;
constexpr int NUP = 1792;
constexpr float EPS_ = 1e-6f;
constexpr float LOG2E = 1.4426950408889634f;
constexpr int NPOS = 5120;
constexpr int NPHASE = 14;
constexpr float PEER_XS = 8.f;

constexpr size_t MiB = 1u << 20;
constexpr size_t WS_CTL = 0, CTL_ZERO_BYTES = 32768;
constexpr size_t WS_WIN = 1 * MiB;
constexpr size_t WS_WUP = 13 * MiB;
constexpr size_t WS_WO3 = 15 * MiB;
constexpr size_t WS_WOUT = 18 * MiB;
constexpr size_t WS_WMKV = 20 * MiB;
constexpr size_t WS_WQ = 22 * MiB;
constexpr size_t WS_KEYS = 26 * MiB;
constexpr size_t WS_CS32 = 27 * MiB;
constexpr size_t WS_CS64 = 27 * MiB + 655360;
constexpr size_t WS_MEMN = 29 * MiB;
constexpr size_t WS_KVM = 33 * MiB;
constexpr size_t WS_KX = 37 * MiB;
constexpr size_t WS_VXT = 39 * MiB;
constexpr size_t WS_SSH = 41 * MiB + 524288;
constexpr size_t WS_SSX = 41 * MiB;
constexpr size_t WS_SUV = 42 * MiB;
constexpr size_t WS_RA = 48 * MiB;
constexpr size_t WS_UP = WS_RA;
constexpr size_t WS_VMT = WS_RA + 112 * MiB;
constexpr size_t WS_OMLA = WS_RA + 144 * MiB;
constexpr size_t WS_RB = 224 * MiB;
constexpr size_t WS_RC = 416 * MiB;
constexpr size_t WS_MERGED = WS_RC;
constexpr size_t WS_QRET = WS_RC;
constexpr size_t WS_KRET = WS_RC + 16 * MiB;
constexpr size_t WS_KRETT = WS_RC + 32 * MiB;
constexpr size_t WS_INCR = WS_RC + 48 * MiB;
constexpr size_t WS_KR = WS_RC + 80 * MiB;
constexpr size_t WS_XN = WS_RA;
constexpr size_t WS_UBF = WS_RA + 64 * MiB;
constexpr size_t WS_VBF = WS_RA + 96 * MiB;
constexpr size_t WS_PQ = WS_RB;
constexpr size_t WS_SC = WS_RB + 128 * MiB;
constexpr size_t WS_EXG = 480 * MiB;
constexpr size_t WS_GTG = 496 * MiB;
constexpr size_t WS_SUG = WS_RC;
constexpr size_t WS_PART = WS_RB;
constexpr size_t WS_END = 512 * MiB;
constexpr size_t DO_N = 0, DO_CQKV = 0, DO_VRT = 32 * MiB, DO_XQ = 64 * MiB, DO_GS = 96 * MiB;

constexpr int LDS_BYTES = 147456;
constexpr int MISC_OFF = LDS_BYTES - 64;

struct Args {
    const float* x; const float* mem; const int* pos;
    const float *attn_norm_g, *w_in, *mla_q_norm_g, *w_uq, *mla_kv_norm_g, *w_ukv, *mla_qn_g, *mla_kn_g, *w_o_mla,
                *ret_gn_g, *w_o_ret, *mem_norm_g, *w_mem_kv, *x_qn_g, *x_kn_g, *w_o_cross, *w_out, *ffn_norm_g,
                *peer_w_q, *peer_keys, *peer_u, *peer_v;
    float* out; unsigned char* ws;
    float invf32[16]; float invf64[32]; float lg2g[4];
    int ph_lo, ph_hi;
};

__device__ __forceinline__ unsigned f2bf(float f) { unsigned u = __builtin_bit_cast(unsigned, f); return (u + 0x7fffu + ((u >> 16) & 1u)) >> 16; }
typedef float f32x2_t __attribute__((ext_vector_type(2))); typedef __bf16 bf16x2_t __attribute__((ext_vector_type(2)));
__device__ __forceinline__ unsigned pk2(float lo, float hi) { const f32x2_t v = {lo, hi}; const bf16x2_t b = __builtin_convertvector(v, bf16x2_t); return __builtin_bit_cast(unsigned, b); }
__device__ __forceinline__ float bflo(unsigned u) { return __builtin_bit_cast(float, u << 16); }
__device__ __forceinline__ float bfhi(unsigned u) { return __builtin_bit_cast(float, u & 0xffff0000u); }
__device__ __forceinline__ float bf1(bf16_t v) { return __builtin_bit_cast(float, ((unsigned)v) << 16); }
__device__ __forceinline__ float ex2(float x) { return __builtin_amdgcn_exp2f(x); }
__device__ __forceinline__ float rsq(float x) { return __builtin_amdgcn_rsqf(x); }
__device__ __forceinline__ float rcp(float x) { return __builtin_amdgcn_rcpf(x); }
__device__ __forceinline__ float sigmoidf_(float x) { return rcp(1.f + ex2(-x * LOG2E)); }
__device__ __forceinline__ float gelu_tanh(float x) { const float u = 0.7978845608028654f * (x + 0.044715f * x * x * x); return x * rcp(1.f + ex2(-2.f * LOG2E * u)); }
__device__ __forceinline__ float wave_sum(float v) {
#pragma unroll
    for (int o = 1; o < 64; o <<= 1) v += __shfl_xor(v, o);
    return v;
}
__device__ __forceinline__ float sum16(float v) {
#pragma unroll
    for (int o = 1; o < 16; o <<= 1) v += __shfl_xor(v, o);
    return v;
}
__device__ __forceinline__ void unpack8(const u32x4 w, float (&f)[8]) {
    f[0] = bflo(w.x); f[1] = bfhi(w.x); f[2] = bflo(w.y); f[3] = bfhi(w.y); f[4] = bflo(w.z); f[5] = bfhi(w.z); f[6] = bflo(w.w); f[7] = bfhi(w.w);
}
__device__ __forceinline__ u32x4 pack8(const float (&f)[8]) { u32x4 w; w.x = pk2(f[0], f[1]); w.y = pk2(f[2], f[3]); w.z = pk2(f[4], f[5]); w.w = pk2(f[6], f[7]); return w; }
__device__ __forceinline__ int crow(int r, int hi) { return (r & 3) + 8 * (r >> 2) + 4 * hi; }
__device__ __forceinline__ f32x16 mfma32(bf16x8 a, bf16x8 b, f32x16 c) { return __builtin_amdgcn_mfma_f32_32x32x16_bf16(a, b, c, 0, 0, 0); }
__device__ __forceinline__ float xmax32(float m) { return fmaxf(m, __shfl_xor(m, 32)); }
__device__ __forceinline__ float xsum32(float m) { return m + __shfl_xor(m, 32); }
#define F16Z ((f32x16){0.f,0.f,0.f,0.f,0.f,0.f,0.f,0.f,0.f,0.f,0.f,0.f,0.f,0.f,0.f,0.f})

#define XB_TMO      128
#define XB_XCNT(j)  (256  + 64 * (j))
#define XB_XSUB(j)  (1280 + 64 * (j))
#define XB_XGEN(j)  (2304 + 64 * (j))
#define XB_TOP      3328
#define XB_TOPGEN   3392
#define XCD_BAR_WORDS 3456
#define XB_SPIN_CAP (1u << 18)
__device__ __forceinline__ unsigned xb_ld(unsigned* p)              { return __hip_atomic_load(p, __ATOMIC_RELAXED, __HIP_MEMORY_SCOPE_AGENT); }
__device__ __forceinline__ unsigned xb_add(unsigned* p, unsigned v) { return __hip_atomic_fetch_add(p, v, __ATOMIC_RELAXED, __HIP_MEMORY_SCOPE_AGENT); }
__device__ __forceinline__ unsigned xb_xcc_id() { return (unsigned)__builtin_amdgcn_s_getreg((3 << 11) | 20) & 0xFu; }
#define XB_SPIN(cond, bar) do { unsigned _sp = 0; while (cond) { __builtin_amdgcn_s_sleep(1); \
    if ((++_sp & 255u) == 0u) { if (xb_ld(&(bar)[XB_TMO])) break; if (_sp > XB_SPIN_CAP) { atomicAdd(&(bar)[XB_TMO], 1u); break; } } } } while (0)
struct XcdBarrier { unsigned* bar; unsigned x; volatile LAS unsigned* st; };
__device__ __forceinline__ XcdBarrier xcd_barrier_post(unsigned* bar, volatile LAS unsigned* st) {
    XcdBarrier b; b.bar = bar; b.x = xb_xcc_id(); b.st = st;
    if (threadIdx.x == 0) (void)xb_add(&bar[XB_XCNT(b.x)], 1u);
    return b;
}
__device__ __forceinline__ void xcd_barrier_complete(unsigned* bar, unsigned x, unsigned& nloc, unsigned& nx) {
    const unsigned G = gridDim.x * gridDim.y * gridDim.z;
    unsigned sum, cnt, mine, sp = 0u;
    for (;;) {
        sum = 0u; cnt = 0u; mine = 0u;
#pragma unroll
        for (unsigned j = 0; j < 16; ++j) { const unsigned c = xb_ld(&bar[XB_XCNT(j)]); sum += c; cnt += (c > 0u) ? 1u : 0u; mine = (j == x) ? c : mine; }
        if (sum == G) break;
        __builtin_amdgcn_s_sleep(1);
        if ((++sp & 255u) == 0u) { if (xb_ld(&bar[XB_TMO])) break; if (sp > XB_SPIN_CAP) { atomicAdd(&bar[XB_TMO], 1u); break; } }
    }
    nloc = mine > 0u ? mine : 1u; nx = cnt > 0u ? cnt : 1u;
}
__device__ __forceinline__ void xcd_barrier(const XcdBarrier& b) {
    asm volatile("s_waitcnt vmcnt(0)" ::: "memory");
    __syncthreads();
    if (threadIdx.x == 0) {
        unsigned* bar = b.bar;
        __builtin_amdgcn_s_waitcnt(0);
        unsigned nloc = b.st[0], nx = b.st[1];
        if (nloc == 0u) { xcd_barrier_complete(bar, b.x, nloc, nx); b.st[0] = nloc; b.st[1] = nx; }
        const unsigned old = xb_add(&bar[XB_XSUB(b.x)], 1u);
        const unsigned gen = old / nloc;
        if (old + 1u == (gen + 1u) * nloc) {
            __builtin_amdgcn_fence(__ATOMIC_RELEASE, "agent");
            asm volatile("s_waitcnt vmcnt(0)" ::: "memory");
            const unsigned og = xb_add(&bar[XB_TOP], 1u);
            const unsigned tg = og / nx;
            if (og + 1u == (tg + 1u) * nx) xb_add(&bar[XB_TOPGEN], 1u);
            else XB_SPIN(xb_ld(&bar[XB_TOPGEN]) == tg, bar);
            __builtin_amdgcn_fence(__ATOMIC_ACQUIRE, "agent");
            xb_add(&bar[XB_XGEN(b.x)], 1u);
            asm volatile("s_waitcnt vmcnt(0)" ::: "memory");
        } else {
            XB_SPIN(xb_ld(&bar[XB_XGEN(b.x)]) == gen, bar);
            __builtin_amdgcn_fence(__ATOMIC_ACQUIRE, "agent");
            asm volatile("s_waitcnt vmcnt(0)" ::: "memory");
        }
    }
    __syncthreads();
}

namespace pg8 {
constexpr int BM = 256, BK = 64, HALF = 128, HTB = HALF * BK * 2, STAGE_BYTES = 8 * HTB, NXCD = 8, WGM = 8;
__host__ __device__ __forceinline__ int lds_byte(int r, int c) { const int st = (r >> 4) * 2 + (c >> 5), rr = r & 15, cc = c & 31, ob = rr * 64 + cc * 2; return st * 1024 + (ob ^ (((ob >> 9) & 1) << 5)); }
__host__ __device__ __forceinline__ void stage_rc(int b, int& R, int& C) { const int st = b / 1024, sb = b % 1024, swz = sb ^ (((sb >> 9) & 1) << 5); R = (st >> 1) * 16 + swz / 64; C = (st & 1) * 32 + (swz % 64) / 2; }
__host__ __device__ __forceinline__ int perm32(int rho) { const int n = rho >> 4, i = rho & 15; return 8 * (i >> 2) + 4 * n + (i & 3); }

struct Unit { int pm, pn; const char* a; const char* b; };
struct Gemm { int lda, ldb, K; };

__device__ __forceinline__ void tile_of(int L, int nM, int nN, int& pm, int& pn) {
    const int nwg = nM * nN; int wgid = L;
    { const int q = nwg / NXCD, r = nwg % NXCD, xcd = wgid % NXCD, off = wgid / NXCD; wgid = (xcd < r ? xcd * (q + 1) : r * (q + 1) + (xcd - r) * q) + off; }
    const int nig = WGM * nN, gid = wgid / nig, fm = gid * WGM, gsz = (nM - fm) < WGM ? (nM - fm) : WGM;
    pm = fm + ((wgid % nig) % gsz); pn = (wgid % nig) / gsz;
}
struct SchedStd {
    int nM, nN, G, c; const char* A; const char* B; size_t a_tile, b_tile, a_pn;
    __device__ __forceinline__ bool next(int i, Unit& u) const {
        const long L = (long)i * G + c; if (L >= (long)nM * nN) return false;
        int pm, pn; tile_of((int)L, nM, nN, pm, pn); u.pm = pm; u.pn = pn;
        u.a = A + (size_t)pm * a_tile + (size_t)pn * a_pn; u.b = B + (size_t)pn * b_tile; return true;
    }
};
struct SchedG4 {
    int G, c; const char* A0; const char* A1; const char* A2; const char* B;
    __device__ __forceinline__ bool next(int i, Unit& u) const {
        const int tile = i / 3, b = i - 3 * tile; const long L = (long)tile * G + c; if (L >= 512) return false;
        int pm, pn; tile_of((int)L, 128, 4, pm, pn); u.pm = pm; u.pn = 4 * b + pn;
        const unsigned long long m0 = b == 0 ? ~0ull : 0ull, m1 = b == 1 ? ~0ull : 0ull, m2 = b == 2 ? ~0ull : 0ull;
        const char* A = (const char*)(((unsigned long long)A0 & m0) | ((unsigned long long)A1 & m1) | ((unsigned long long)A2 & m2));
        u.a = A + (size_t)pm * (256 * 512 * 2); u.b = B + (size_t)(4 * b + pn) * (256 * 512 * 2); return true;
    }
};

struct EpiBf16 {
    static constexpr bool PERM = true;
    bf16_t* O; int ldc;
    __device__ __forceinline__ void operator()(const f32x4 (&acc)[2][2][4][2], const Unit& u, int wr, int wc, int fr, int fq) const {
        const int row0 = u.pm * BM + wr * 64 + fr, col0 = u.pn * BM + wc * 32 + 8 * fq;
#pragma unroll
        for (int ai = 0; ai < 2; ++ai)
#pragma unroll
            for (int m = 0; m < 4; ++m) { bf16_t* rowp = O + (size_t)(row0 + ai * HALF + m * 16) * ldc + col0;
#pragma unroll
                for (int bj = 0; bj < 2; ++bj) { const f32x4 v0 = acc[ai][bj][m][0], v1 = acc[ai][bj][m][1];
                    u32x4 w; w.x = pk2(v0[0], v0[1]); w.y = pk2(v0[2], v0[3]); w.z = pk2(v1[0], v1[1]); w.w = pk2(v1[2], v1[3]);
                    *(u32x4*)(rowp + bj * HALF) = w; } }
    }
};
struct EpiProj {
    static constexpr bool PERM = true;
    bf16_t* PA; bf16_t* GT; bf16_t* QR; bf16_t* KR; bf16_t* GS; bf16_t* XQ; float* SSX; const int* POS; const f32x2* CS64;
    __device__ __forceinline__ void operator()(const f32x4 (&acc)[2][2][4][2], const Unit& u, int wr, int wc, int fr, int fq) const {
        const int pn = u.pn;
        const int row0 = u.pm * BM + wr * 64 + fr, cin = wc * 32 + 8 * fq;
        if (pn == 2 || pn == 3) {
            const unsigned long long mq = pn == 2 ? ~0ull : 0ull;
            bf16_t* dst = (bf16_t*)(((unsigned long long)QR & mq) | ((unsigned long long)KR & ~mq)); const float sc = pn == 2 ? 1.f : 0.125f; const int jg = 4 * (wc & 1) + fq;
#pragma unroll
            for (int ai = 0; ai < 2; ++ai)
#pragma unroll
                for (int m = 0; m < 4; ++m) { const int row = row0 + ai * HALF + m * 16; const int p = POS[row]; const int pc = p < 0 ? 0 : (p >= NPOS ? NPOS - 1 : p);
                    const f32x4 t0 = *(const f32x4*)(CS64 + (size_t)pc * 32 + 4 * jg), t1 = *(const f32x4*)(CS64 + (size_t)pc * 32 + 4 * jg + 2);
#pragma unroll
                    for (int bj = 0; bj < 2; ++bj) { const f32x4 v0 = acc[ai][bj][m][0], v1 = acc[ai][bj][m][1]; const int head = 2 * bj + (wc >> 1);
                        u32x4 w;
                        w.x = pk2((v0[0] * t0.x - v1[0] * t0.y) * sc, (v0[1] * t0.z - v1[1] * t0.w) * sc); w.y = pk2((v0[2] * t1.x - v1[2] * t1.y) * sc, (v0[3] * t1.z - v1[3] * t1.w) * sc);
                        w.z = pk2((v0[0] * t0.y + v1[0] * t0.x) * sc, (v0[1] * t0.w + v1[1] * t0.z) * sc); w.w = pk2((v0[2] * t1.y + v1[2] * t1.x) * sc, (v0[3] * t1.w + v1[3] * t1.z) * sc);
                        *(u32x4*)(dst + (size_t)row * 256 + head * 64 + 8 * jg) = w; } }
            return;
        }
        if (pn == 8 || pn == 9) {
#pragma unroll
            for (int ai = 0; ai < 2; ++ai)
#pragma unroll
                for (int m = 0; m < 4; ++m) { const int row = row0 + ai * HALF + m * 16;
#pragma unroll
                    for (int bj = 0; bj < 2; ++bj) { const f32x4 v0 = acc[ai][bj][m][0], v1 = acc[ai][bj][m][1]; const int head = 2 * (pn - 8) + bj;
                        float ss = (v0[0] * v0[0] + v0[1] * v0[1]) + (v0[2] * v0[2] + v0[3] * v0[3]) + (v1[0] * v1[0] + v1[1] * v1[1]) + (v1[2] * v1[2] + v1[3] * v1[3]);
                        ss += __shfl_xor(ss, 16); ss += __shfl_xor(ss, 32);
                        if (fq == 0) atomicAdd(SSX + (size_t)row * 4 + head, ss);
                        u32x4 w; w.x = pk2(v0[0], v0[1]); w.y = pk2(v0[2], v0[3]); w.z = pk2(v1[0], v1[1]); w.w = pk2(v1[2], v1[3]);
                        *(u32x4*)(XQ + (size_t)row * 512 + head * 128 + cin) = w; } }
            return;
        }
        if (pn >= 11) {
            const int tid_ = ((wr * 4 + wc) * 4 + fq) * 16 + fr;
            bf16_t* gb = GT + ((((size_t)u.pm * 12 + (pn - 11)) * 16) * 512 + tid_) * 8;
#pragma unroll
            for (int ai = 0; ai < 2; ++ai)
#pragma unroll
                for (int m = 0; m < 4; ++m)
#pragma unroll
                    for (int bj = 0; bj < 2; ++bj) { f32x4 v0 = acc[ai][bj][m][0], v1 = acc[ai][bj][m][1];
#pragma unroll
                        for (int e = 0; e < 4; ++e) { v0[e] = rcp(1.f + ex2(v0[e])); v1[e] = rcp(1.f + ex2(v1[e])); }
                        u32x4 w; w.x = pk2(v0[0], v0[1]); w.y = pk2(v0[2], v0[3]); w.z = pk2(v1[0], v1[1]); w.w = pk2(v1[2], v1[3]);
                        *(u32x4*)(gb + (size_t)(ai * 8 + m * 2 + bj) * 4096) = w; }
            return;
        }
        if (pn == 10 && wc != 0) return;
        const bool isg = false, issl = (pn == 6 || pn == 7);
        const unsigned long long mg = 0ull, ms = issl ? ~0ull : 0ull;
        bf16_t* base = (bf16_t*)(((unsigned long long)GT & mg) | ((unsigned long long)GS & ms) | ((unsigned long long)PA & ~(mg | ms))); const int ldc = issl ? 512 : NPA;
        const int col0 = (issl ? pn - 6 : pn) * BM + cin;
#pragma unroll
        for (int ai = 0; ai < 2; ++ai)
#pragma unroll
            for (int m = 0; m < 4; ++m) { bf16_t* rowp = base + (size_t)(row0 + ai * HALF + m * 16) * ldc + col0;
#pragma unroll
                for (int bj = 0; bj < 2; ++bj) { f32x4 v0 = acc[ai][bj][m][0], v1 = acc[ai][bj][m][1];
                    if (pn == 10 && bj != 0) continue;
                    if (isg) {
#pragma unroll
                        for (int e = 0; e < 4; ++e) { v0[e] = sigmoidf_(v0[e]); v1[e] = sigmoidf_(v1[e]); } }
                    if (issl) {
#pragma unroll
                        for (int e = 0; e < 4; ++e) { v0[e] = v0[e] * sigmoidf_(v0[e]); v1[e] = v1[e] * sigmoidf_(v1[e]); } }
                    u32x4 w; w.x = pk2(v0[0], v0[1]); w.y = pk2(v0[2], v0[3]); w.z = pk2(v1[0], v1[1]); w.w = pk2(v1[2], v1[3]);
                    *(u32x4*)(rowp + bj * HALF) = w; } }
    }
};
struct EpiGate {
    static constexpr bool PERM = true;
    bf16_t* GT; bf16_t* MG;
    __device__ __forceinline__ void operator()(const f32x4 (&acc)[2][2][4][2], const Unit& u, int wr, int wc, int fr, int fq) const {
        const int b = u.pn >> 2, pn = u.pn & 3;
        const int row0 = u.pm * BM + wr * 64 + fr, col0 = pn * BM + wc * 32 + 8 * fq;
        const int tid_ = ((wr * 4 + wc) * 4 + fq) * 16 + fr;
        const bf16_t* gb = GT + ((((size_t)u.pm * 12 + u.pn) * 16) * 512 + tid_) * 8;
        bf16_t* pb = GT + ((((size_t)u.pm * 12 + pn) * 16) * 512 + tid_) * 8;
#pragma unroll
        for (int ai = 0; ai < 2; ++ai) {
            u32x4 gw[4][2], pw[4][2];
#pragma unroll
            for (int m = 0; m < 4; ++m)
#pragma unroll
                for (int bj = 0; bj < 2; ++bj) { const size_t ko = (size_t)(ai * 8 + m * 2 + bj) * 4096;
                    gw[m][bj] = *(const u32x4*)(gb + ko); pw[m][bj] = (b > 0) ? *(const u32x4*)(pb + ko) : (u32x4){0u, 0u, 0u, 0u}; }
#pragma unroll
            for (int m = 0; m < 4; ++m)
#pragma unroll
                for (int bj = 0; bj < 2; ++bj) {
                    const f32x4 v0 = acc[ai][bj][m][0], v1 = acc[ai][bj][m][1];
                    float g[8], p[8], r[8]; unpack8(gw[m][bj], g); unpack8(pw[m][bj], p);
                    r[0] = g[0] * v0[0] + p[0]; r[1] = g[1] * v0[1] + p[1]; r[2] = g[2] * v0[2] + p[2]; r[3] = g[3] * v0[3] + p[3];
                    r[4] = g[4] * v1[0] + p[4]; r[5] = g[5] * v1[1] + p[5]; r[6] = g[6] * v1[2] + p[6]; r[7] = g[7] * v1[3] + p[7];
                    if (b < 2) *(u32x4*)(pb + (size_t)(ai * 8 + m * 2 + bj) * 4096) = pack8(r);
                    else *(u32x4*)(MG + (size_t)(row0 + ai * HALF + m * 16) * 1024 + col0 + bj * HALF) = pack8(r); }
        }
    }
};
struct EpiRes {
    static constexpr bool PERM = true;
    float* C; const float* X; bf16_t* HB; float* SS;
    __device__ __forceinline__ void operator()(const f32x4 (&acc)[2][2][4][2], const Unit& u, int wr, int wc, int fr, int fq) const {
        const int row0 = u.pm * BM + wr * 64 + fr, col0 = u.pn * BM + wc * 32 + 8 * fq;
#pragma unroll
        for (int ai = 0; ai < 2; ++ai) {
            f32x4 xv[4][2][2];
#pragma unroll
            for (int m = 0; m < 4; ++m)
#pragma unroll
                for (int bj = 0; bj < 2; ++bj)
#pragma unroll
                    for (int n = 0; n < 2; ++n) xv[m][bj][n] = *(const f32x4*)(X + (size_t)(row0 + ai * HALF + m * 16) * 1024 + col0 + bj * HALF + n * 4);
#pragma unroll
            for (int m = 0; m < 4; ++m) { const size_t ro = (size_t)(row0 + ai * HALF + m * 16) * 1024 + col0; float ss = 0.f;
#pragma unroll
                for (int bj = 0; bj < 2; ++bj) { const f32x4 h0 = acc[ai][bj][m][0] + xv[m][bj][0], h1 = acc[ai][bj][m][1] + xv[m][bj][1];
                    *(f32x4*)(C + ro + bj * HALF) = h0; *(f32x4*)(C + ro + bj * HALF + 4) = h1;
                    *(u32x4*)(HB + ro + bj * HALF) = (u32x4){pk2(h0.x, h0.y), pk2(h0.z, h0.w), pk2(h1.x, h1.y), pk2(h1.z, h1.w)};
                    ss += ((h0.x * h0.x + h0.y * h0.y) + (h0.z * h0.z + h0.w * h0.w)) + ((h1.x * h1.x + h1.y * h1.y) + (h1.z * h1.z + h1.w * h1.w)); }
                ss += __shfl_xor(ss, 16); ss += __shfl_xor(ss, 32);
                if (fq == 0) atomicAdd(SS + row0 + ai * HALF + m * 16, ss); }
        }
    }
};
struct EpiBf16S {
    static constexpr bool PERM = true;
    bf16_t* O; int ldc; const float* SS;
    __device__ __forceinline__ void operator()(const f32x4 (&acc)[2][2][4][2], const Unit& u, int wr, int wc, int fr, int fq) const {
        const int row0 = u.pm * BM + wr * 64 + fr, col0 = u.pn * BM + wc * 32 + 8 * fq;
#pragma unroll
        for (int ai = 0; ai < 2; ++ai)
#pragma unroll
            for (int m = 0; m < 4; ++m) { const int row = row0 + ai * HALF + m * 16; const float rs = rsq(SS[row] * (1.f / 1024.f) + EPS_); bf16_t* rowp = O + (size_t)row * ldc + col0;
#pragma unroll
                for (int bj = 0; bj < 2; ++bj) { const f32x4 v0 = acc[ai][bj][m][0] * rs, v1 = acc[ai][bj][m][1] * rs;
                    u32x4 w; w.x = pk2(v0[0], v0[1]); w.y = pk2(v0[2], v0[3]); w.z = pk2(v1[0], v1[1]); w.w = pk2(v1[2], v1[3]);
                    *(u32x4*)(rowp + bj * HALF) = w; } }
    }
};

template <class Epi, class Sched>
__device__ __forceinline__ void gemm_phase(LAS unsigned char* lds, const Gemm g, const Sched& S, const Epi& E) {
    const int tid = threadIdx.x, wid = __builtin_amdgcn_readfirstlane(tid >> 6), lane = tid & 63, wr = wid >> 2, wc = wid & 3, fr = lane & 15, fq = lane >> 4;
    const int K = g.K, nt = K / BK;
    unsigned voffA[2], voffB[2];
#pragma unroll
    for (int i = 0; i < 2; ++i) { int R, C; stage_rc(tid * 16 + i * 8192, R, C); const int Rb = Epi::PERM ? ((R & ~31) + perm32(R & 31)) : R;
        voffA[i] = (unsigned)(R * g.lda + C) * 2u; voffB[i] = (unsigned)(Rb * g.ldb + C) * 2u; }
    const size_t kstep = (size_t)(BK * 2);
    const size_t hstepA = (size_t)HALF * g.lda * 2, hstepB = (size_t)HALF * g.ldb * 2;
    const unsigned ldsw = (unsigned)wid * 1024u;
    const int aoff = lds_byte(wr * 64 + fr, fq * 8), boff = lds_byte(wc * 32 + fr, fq * 8);
#define PG8_SA(b, h) (((b) * 2 + (h)) * HTB)
#define PG8_SB(b, h) ((4 + (b) * 2 + (h)) * HTB)
#define PG8_STAGE(bufoff, gbase, voff) do { _Pragma("unroll") for (int _i = 0; _i < 2; ++_i) \
        __builtin_amdgcn_global_load_lds((const unsigned*)((const char*)(gbase) + (voff)[_i]), (LAS unsigned*)(lds + (bufoff) + ldsw + _i * 8192), 16, 0, 0); } while (0)
#define PG8_LDA(dst, b, h) do { _Pragma("unroll") for (int m = 0; m < 4; ++m) _Pragma("unroll") for (int k = 0; k < 2; ++k) dst[m][k] = *(const LAS bf16x8*)(lds + PG8_SA(b, h) + aoff + m * 2048 + k * 1024); } while (0)
#define PG8_LDB(dst, b, h) do { _Pragma("unroll") for (int n = 0; n < 2; ++n) _Pragma("unroll") for (int k = 0; k < 2; ++k) dst[n][k] = *(const LAS bf16x8*)(lds + PG8_SB(b, h) + boff + n * 2048 + k * 1024); } while (0)
#define PG8_MMA(ai, bj, At, Bt) do { __builtin_amdgcn_s_setprio(1); _Pragma("unroll") for (int m = 0; m < 4; ++m) _Pragma("unroll") for (int n = 0; n < 2; ++n) _Pragma("unroll") for (int k = 0; k < 2; ++k) \
        acc[ai][bj][m][n] = __builtin_amdgcn_mfma_f32_16x16x32_bf16(Bt[n][k], At[m][k], acc[ai][bj][m][n], 0, 0, 0); __builtin_amdgcn_s_setprio(0); } while (0)
#define PG8_WAIT_V(n) asm volatile("s_waitcnt vmcnt(" #n ")" ::: "memory")
#define PG8_WAIT_L(n) asm volatile("s_waitcnt lgkmcnt(" #n ")" ::: "memory")
#define PG8_BAR __builtin_amdgcn_s_barrier()
#define PG8_SCHED __builtin_amdgcn_sched_barrier(0)
    Unit cur, nxt; int ui = 0;
    if (!S.next(0, cur)) return;
    f32x4 acc[2][2][4][2];
#pragma unroll
    for (int a = 0; a < 2; ++a)
#pragma unroll
        for (int b = 0; b < 2; ++b)
#pragma unroll
            for (int m = 0; m < 4; ++m)
#pragma unroll
                for (int n = 0; n < 2; ++n) acc[a][b][m][n] = (f32x4){0.f, 0.f, 0.f, 0.f};
    bf16x8 At[4][2], B0[2][2], B1[2][2];
    const char* cA = cur.a; const char* cB = cur.b;
    PG8_STAGE(PG8_SB(0, 0), cB, voffB); PG8_STAGE(PG8_SA(0, 0), cA, voffA); PG8_STAGE(PG8_SB(0, 1), cB + hstepB, voffB); PG8_STAGE(PG8_SA(0, 1), cA + hstepA, voffA);
    if (wr == 1) PG8_BAR;
    PG8_WAIT_V(4); PG8_BAR;
    PG8_STAGE(PG8_SB(1, 0), cB + kstep, voffB); PG8_STAGE(PG8_SA(1, 0), cA + kstep, voffA); PG8_STAGE(PG8_SB(1, 1), cB + hstepB + kstep, voffB);
    PG8_WAIT_V(6); PG8_BAR;
    for (;;) {
        const bool has_next = S.next(ui + 1, nxt);
        const char* nA = has_next ? nxt.a : cA; const char* nB = has_next ? nxt.b : cB;
        for (int t = 0; t < nt; t += 2) {
            const bool last = (t == nt - 2);
            const char* a1 = cA + (size_t)(t + 1) * kstep;
            const char* a2 = last ? nA : cA + (size_t)(t + 2) * kstep; const char* b2 = last ? nB : cB + (size_t)(t + 2) * kstep;
            const char* a3 = a2 + kstep; const char* b3 = b2 + kstep;
            PG8_LDB(B0, 0, 0); PG8_SCHED; PG8_LDA(At, 0, 0); PG8_STAGE(PG8_SA(1, 1), a1 + hstepA, voffA);
            PG8_WAIT_L(8); PG8_BAR; PG8_WAIT_L(0); PG8_MMA(0, 0, At, B0); PG8_BAR; PG8_SCHED;
            PG8_LDB(B1, 0, 1); PG8_STAGE(PG8_SB(0, 0), b2, voffB);
            PG8_BAR; PG8_WAIT_L(0); PG8_MMA(0, 1, At, B1); PG8_BAR;
            PG8_LDA(At, 0, 1); PG8_STAGE(PG8_SA(0, 0), a2, voffA);
            PG8_BAR; PG8_WAIT_L(0); PG8_MMA(1, 0, At, B0); PG8_BAR; PG8_SCHED;
            PG8_STAGE(PG8_SB(0, 1), b2 + hstepB, voffB);
            PG8_WAIT_V(6); PG8_BAR; PG8_MMA(1, 1, At, B1); PG8_BAR;
            PG8_LDB(B0, 1, 0); PG8_SCHED; PG8_LDA(At, 1, 0); PG8_STAGE(PG8_SA(0, 1), a2 + hstepA, voffA);
            PG8_WAIT_L(8); PG8_BAR; PG8_WAIT_L(0); PG8_MMA(0, 0, At, B0); PG8_BAR; PG8_SCHED;
            PG8_LDB(B1, 1, 1); PG8_STAGE(PG8_SB(1, 0), b3, voffB);
            PG8_BAR; PG8_WAIT_L(0); PG8_MMA(0, 1, At, B1); PG8_BAR;
            PG8_LDA(At, 1, 1); PG8_STAGE(PG8_SA(1, 0), a3, voffA);
            PG8_BAR; PG8_WAIT_L(0); PG8_MMA(1, 0, At, B0); PG8_BAR; PG8_SCHED;
            PG8_STAGE(PG8_SB(1, 1), b3 + hstepB, voffB);
            PG8_WAIT_V(6); PG8_BAR; PG8_MMA(1, 1, At, B1); PG8_BAR;
        }
        E(acc, cur, wr, wc, fr, fq);
        if (!has_next) break;
#pragma unroll
        for (int a = 0; a < 2; ++a)
#pragma unroll
            for (int b = 0; b < 2; ++b)
#pragma unroll
                for (int m = 0; m < 4; ++m)
#pragma unroll
                    for (int n = 0; n < 2; ++n) acc[a][b][m][n] = (f32x4){0.f, 0.f, 0.f, 0.f};
        cur = nxt; cA = nA; cB = nB; ++ui;
    }
    PG8_WAIT_V(0);
    if (wr == 0) PG8_BAR;
    PG8_BAR;
#undef PG8_SA
#undef PG8_SB
#undef PG8_STAGE
#undef PG8_LDA
#undef PG8_LDB
#undef PG8_MMA
#undef PG8_WAIT_V
#undef PG8_WAIT_L
#undef PG8_BAR
#undef PG8_SCHED
}
}

template <class F>
__device__ __forceinline__ void tr_tile(F f, bf16_t* dst, int ldd, int j0, int k0, LAS float* scr) {
    const int tid = threadIdx.x, tx = tid & 63, ty = tid >> 6;
#pragma unroll
    for (int i = 0; i < 8; ++i) { const int kk = ty + 8 * i; scr[kk * 65 + tx] = f(k0 + kk, j0 + tx); }
    __syncthreads();
    { const int jj = tid >> 3, c = tid & 7; const LAS float* s = scr + (8 * c) * 65 + jj;
      u32x4 o; o.x = pk2(s[0], s[65]); o.y = pk2(s[2 * 65], s[3 * 65]); o.z = pk2(s[4 * 65], s[5 * 65]); o.w = pk2(s[6 * 65], s[7 * 65]);
      *(u32x4*)(dst + (size_t)(j0 + jj) * ldd + k0 + 8 * c) = o; }
    __syncthreads();
}
__device__ __forceinline__ int win_src_col(int j) {
    if (j < 512) return j;
    if (j >= 512 && j < 1024) { const int loc = j - 512, hh = loc >> 6, sl = loc & 63, jg = sl >> 3, e = sl & 7; return 544 + hh * 64 + ((e < 4) ? 4 * jg + e : 32 + 4 * jg + (e - 4)); }
    if (j < 2560) return j + 32;
    if (j < 2592) return j - 2048;
    if (j < 2816) return -1;
    return j - 224;
}
__device__ __forceinline__ void sincos_d(float ang, float& c, float& s) {
    const double TWO_PI = 6.283185307179586476925;
    double x = (double)ang; const double n = __builtin_rint(x * (1.0 / TWO_PI)); x -= n * TWO_PI;
    const double x2 = x * x;
    const double SC[16] = {1.0, -0.16666666666666666, 0.008333333333333333, -0.0001984126984126984, 2.7557319223985893e-06, -2.505210838544172e-08, 1.6059043836821613e-10, -7.647163731819816e-13,
                           2.8114572543455206e-15, -8.22063524662433e-18, 1.9572941063391263e-20, -3.868170170630684e-23, 6.446950284384474e-26, -9.183689863795546e-29, 1.1309962886447716e-31, -1.216125041553518e-34};
    const double CC[16] = {1.0, -0.5, 0.041666666666666664, -0.001388888888888889, 2.48015873015873e-05, -2.755731922398589e-07, 2.08767569878681e-09, -1.1470745597729725e-11,
                           4.779477332387385e-14, -1.5619206968586225e-16, 4.110317623312165e-19, -8.896791392450574e-22, 1.6117375710961184e-24, -2.4795962632247976e-27, 3.279889237069838e-30, -3.7699876288159054e-33};
    double ps = SC[15], pc = CC[15];
#pragma unroll
    for (int k = 14; k >= 0; --k) { ps = __builtin_fma(ps, x2, SC[k]); pc = __builtin_fma(pc, x2, CC[k]); }
    c = (float)pc; s = (float)(ps * x);
}
template <int NR>
__device__ __forceinline__ void rms_rows_to_bf16(const float* __restrict__ xrow, const float* __restrict__ g, bf16_t* __restrict__ orow, int lane) {
    f32x4 v[NR][4];
#pragma unroll
    for (int r = 0; r < NR; ++r)
#pragma unroll
        for (int j = 0; j < 4; ++j) v[r][j] = ((const f32x4*)(xrow + (size_t)r * 1024) + lane)[64 * j];
    const f32x4* gr = (const f32x4*)g + lane;
    f32x4 gg[4];
#pragma unroll
    for (int j = 0; j < 4; ++j) gg[j] = gr[64 * j];
#pragma unroll
    for (int r = 0; r < NR; ++r) {
        float s = 0.f;
#pragma unroll
        for (int j = 0; j < 4; ++j) s += (v[r][j].x * v[r][j].x + v[r][j].y * v[r][j].y) + (v[r][j].z * v[r][j].z + v[r][j].w * v[r][j].w);
        const float rinv = rsq(wave_sum(s) * (1.f / 1024.f) + EPS_);
        u32x2* o8 = (u32x2*)(orow + (size_t)r * 1024) + lane;
#pragma unroll
        for (int j = 0; j < 4; ++j) { u32x2 w; w.x = pk2(v[r][j].x * rinv * gg[j].x, v[r][j].y * rinv * gg[j].y); w.y = pk2(v[r][j].z * rinv * gg[j].z, v[r][j].w * rinv * gg[j].w); o8[64 * j] = w; }
    }
}

__device__ __forceinline__ void p0_prologue(const Args& a, LAS unsigned char* lds) {
    const int tid = threadIdx.x, lane = tid & 63, wave = tid >> 6, G = gridDim.x, bx = blockIdx.x;
    LAS float* scr = (LAS float*)lds;
    unsigned char* ws = a.ws;
    constexpr int I_WIN = (NG1 / 64) * 16, I_WUP = (NUP / 64) * 8, I_WO3 = 48 * 8, I_WOUT = 16 * 16, I_WMKV = 16 * 16, I_WQ = 32 * 16;
    constexpr int NIT = I_WIN + I_WUP + I_WO3 + I_WOUT + I_WMKV + I_WQ;
    const int gt = bx * 512 + tid, NT = G * 512;
    for (int i = gt; i < 8 * 2 * 128 * 16; i += NT) {
        const float* src = a.peer_keys + (size_t)i * 8;
        const f32x4 p = *(const f32x4*)src, q = *(const f32x4*)(src + 4);
        const int dg = i & 15, n = (i >> 4) & 127, hc = i >> 11; const size_t di = ((((size_t)hc * 4 + (n >> 5)) * 8 + (dg >> 1)) * 64 + (dg & 1) * 32 + (n & 31));
        *(u32x4*)((bf16_t*)(ws + WS_KEYS) + di * 8) = (u32x4){pk2(p.x, p.y), pk2(p.z, p.w), pk2(q.x, q.y), pk2(q.z, q.w)};
    }
    for (int i = gt; i < T_; i += NT) *(f32x4*)((float*)(ws + WS_SSX) + (size_t)i * 4) = (f32x4){0.f, 0.f, 0.f, 0.f};
    for (int i = gt; i < T_; i += NT) ((float*)(ws + WS_SSH))[i] = 0.f;
    for (int i = gt; i < NPOS * 48; i += NT) {
        const int p = i / 48, f = i % 48; float c, s;
        if (f < 16) { sincos_d((float)p * a.invf32[f], c, s); ((f32x2*)(ws + WS_CS32))[p * 16 + f] = (f32x2){c, s}; }
        else { sincos_d((float)p * a.invf64[f - 16], c, s); ((f32x2*)(ws + WS_CS64))[p * 32 + (f - 16)] = (f32x2){c, s}; }
    }
    const int gw = bx * 8 + wave, NGW = G * 8;
    bf16_t* nb = (bf16_t*)((unsigned char*)a.out + DO_N);
    const bool flip0 = ((bx >> 3) & 1) != 0;
#pragma unroll 1
    for (int st = 0; st < 2; ++st) {
        if ((flip0 ? 1 - st : st) == 0) {
    for (int it = bx; it < NIT; it += G) {
        int r = it;
        if (r < I_WIN) { const int jt = r / 16, kt = r % 16; const float* W = a.w_in;
            tr_tile([=](int k, int j) { const int c = win_src_col(j); return c >= 0 ? W[(size_t)k * 5664 + c] * (j >= 2816 ? -LOG2E : 1.f) : 0.f; }, (bf16_t*)(ws + WS_WIN), 1024, jt * 64, kt * 64, scr); continue; } r -= I_WIN;
        if (r < I_WUP) { const int jt = r / 8, kt = r % 8; const float* Wq = a.w_uq; const float* Wk = a.w_ukv;
            tr_tile([=](int k, int j) { return j < 768 ? (k < 384 ? Wq[(size_t)k * 768 + j] : 0.f) : (k >= 384 ? Wk[(size_t)(k - 384) * 1024 + (j - 768)] : 0.f); }, (bf16_t*)(ws + WS_WUP), 512, jt * 64, kt * 64, scr); continue; } r -= I_WUP;
        if (r < I_WO3) { const int jt = r / 8, kt = r % 8; const int b = jt / 16; const float* W = b == 0 ? a.w_o_mla : (b == 1 ? a.w_o_ret : a.w_o_cross);
            tr_tile([=](int k, int j) { return W[(size_t)k * 1024 + (j & 1023)]; }, (bf16_t*)(ws + WS_WO3), 512, jt * 64, kt * 64, scr); continue; } r -= I_WO3;
        if (r < I_WOUT) { const int jt = r / 16, kt = r % 16; const float* W = a.w_out;
            tr_tile([=](int k, int j) { return W[(size_t)k * 1024 + j]; }, (bf16_t*)(ws + WS_WOUT), 1024, jt * 64, kt * 64, scr); continue; } r -= I_WOUT;
        if (r < I_WMKV) { const int jt = r / 16, kt = r % 16; const float* W = a.w_mem_kv;
            tr_tile([=](int k, int j) { return W[(size_t)k * 1024 + j]; }, (bf16_t*)(ws + WS_WMKV), 1024, jt * 64, kt * 64, scr); continue; } r -= I_WMKV;
        { const int jt = r / 16, kt = r % 16; const float* W = a.peer_w_q;
            const float* gn = a.ffn_norm_g; tr_tile([=](int k, int j) { return W[(size_t)k * 2048 + j] * gn[k]; }, (bf16_t*)(ws + WS_WQ), 1024, jt * 64, kt * 64, scr); }
    }
        } else {
    for (int m = gw * 4; m < T_; m += NGW * 4) rms_rows_to_bf16<4>(a.x + (size_t)m * 1024, a.attn_norm_g, nb + (size_t)m * 1024, lane);
    for (int m = gw; m < B_ * MEM_; m += NGW) rms_rows_to_bf16<1>(a.mem + (size_t)m * 1024, a.mem_norm_g, (bf16_t*)(ws + WS_MEMN) + (size_t)m * 1024, lane);
        }
    }
}

__device__ __forceinline__ int tr_slot(int tl, int ch) { return ch ^ ((tl >> 3) & 7); }
__device__ __forceinline__ void tr_store_cols(const LAS unsigned char* tile, int pitchB, int ncol, bf16_t* dst, size_t ldd, int s0, int ngrp = 8) {
    const int c = threadIdx.x & 7; if (c >= ngrp) return;
    for (int col = threadIdx.x >> 3; col < ncol; col += 64) {
        const LAS unsigned char* p = tile + (8 * c) * pitchB + ((col >> 3) ^ c) * 16 + (col & 7) * 2;
        unsigned w[4];
#pragma unroll
        for (int e = 0; e < 4; ++e) { const unsigned lo = *(const LAS bf16_t*)(p + (2 * e) * pitchB), hi = *(const LAS bf16_t*)(p + (2 * e + 1) * pitchB); w[e] = lo | (hi << 16); }
        *(u32x4*)(dst + (size_t)col * ldd + s0 + 8 * c) = (u32x4){w[0], w[1], w[2], w[3]};
    }
}
constexpr int P2_VT_PITCH = 1040, P2_KT_PITCH = 528, P2_KT_OFF = 64 * P2_VT_PITCH;

__device__ __forceinline__ void p2_post_proj(const Args& a, LAS unsigned char* lds) {
    const int tid = threadIdx.x, lane = tid & 63, wave = tid >> 6, G = gridDim.x, bx = blockIdx.x;
    unsigned char* ws = a.ws; unsigned char* dob = (unsigned char*)a.out;
    const bf16_t* PA = (const bf16_t*)(ws + WS_RA);
    bf16_t* cqkvn = (bf16_t*)(dob + DO_CQKV); bf16_t* gsilu = (bf16_t*)(dob + DO_GS); bf16_t* xqn = (bf16_t*)(dob + DO_XQ); bf16_t* vretT = (bf16_t*)(dob + DO_VRT);
    bf16_t* qret = (bf16_t*)(ws + WS_QRET); bf16_t* kret = (bf16_t*)(ws + WS_KRET); bf16_t* kretT = (bf16_t*)(ws + WS_KRETT); bf16_t* krb = (bf16_t*)(ws + WS_KR);
    const f32x2* cs64 = (const f32x2*)(ws + WS_CS64);
    const float xq_scale = 0.08838834764831845f * LOG2E;
    for (int it = bx; it < 512 + 128; it += G) {
        __syncthreads();
        if (it < 512) {
            const int t0 = it * 64, b = t0 >> 12, s0 = t0 & 4095;
            for (int i = 0; i < 8; i += 2) {
                u32x4 wA[2], wV[2], wK[2]; u32x2 wR[2];
#pragma unroll
                for (int j = 0; j < 2; ++j) { const int t = t0 + wave * 8 + i + j; const bf16_t* row = PA + (size_t)t * NPA;
                    wA[j] = *(const u32x4*)(row + 8 * lane); wV[j] = *(const u32x4*)(row + 1024 + 8 * lane);
                    wK[j] = *(const u32x4*)(row + 2560 + 8 * (lane & 3));
                    wR[j] = *(const u32x2*)(kret + (size_t)t * 256 + 4 * lane); }
#pragma unroll
                for (int j = 0; j < 2; ++j) { const int tl = wave * 8 + i + j, t = t0 + tl;
                    { float f[8]; unpack8(wA[j], f); float ss = 0.f;
#pragma unroll
                      for (int e = 0; e < 8; ++e) ss += f[e] * f[e];
                      const float sq = wave_sum(lane < 48 ? ss : 0.f), skv = wave_sum(lane >= 48 ? ss : 0.f);
                      const float rinv = lane < 48 ? rsq(sq * (1.f / 384.f) + EPS_) : rsq(skv * (1.f / 128.f) + EPS_);
                      const float* gp = lane < 48 ? a.mla_q_norm_g + 8 * lane : a.mla_kv_norm_g + 8 * (lane - 48);
#pragma unroll
                      for (int e = 0; e < 8; ++e) f[e] *= rinv * gp[e];
                      *(u32x4*)(cqkvn + (size_t)t * 512 + 8 * lane) = pack8(f); }
                    if (lane < 4) *(u32x4*)(krb + (size_t)t * 32 + 8 * lane) = wK[j];
                    *(LAS u32x4*)(lds + tl * P2_VT_PITCH + tr_slot(tl, lane) * 16) = wV[j];
                    *(LAS u32x2*)(lds + P2_KT_OFF + tl * P2_KT_PITCH + tr_slot(tl, lane >> 1) * 16 + (lane & 1) * 8) = wR[j];
                }
            }
            __syncthreads();
            tr_store_cols(lds, P2_VT_PITCH, 512, vretT + (size_t)b * 512 * S_, S_, s0);
            tr_store_cols(lds + P2_KT_OFF, P2_KT_PITCH, 256, kretT + (size_t)b * 256 * S_, S_, s0);
        } else {
            const int m0 = (it - 512) * 16, b = m0 >> 8, ms0 = m0 & 255;
            const bf16_t* KVM = (const bf16_t*)(ws + WS_KVM); bf16_t* kx = (bf16_t*)(ws + WS_KX); bf16_t* vxT = (bf16_t*)(ws + WS_VXT);
            for (int i = 0; i < 2; ++i) {
                const int tl = wave * 2 + i, mrow = m0 + tl; const bf16_t* row = KVM + (size_t)mrow * 1024;
#pragma unroll
                for (int half = 0; half < 2; ++half) {
                    const int ci = lane + 64 * half, h = ci >> 5, wi = ci & 31;
                    const u32x4 w = *(const u32x4*)(row + 8 * ci); float f[8]; unpack8(w, f); float ss = 0.f;
#pragma unroll
                    for (int e = 0; e < 8; ++e) ss += f[e] * f[e];
                    const float tot = sum16(ss);
                    if (wi < 16) { const float rinv = rsq(tot * (1.f / 128.f) + EPS_); const float* gp = a.x_kn_g + 8 * wi; const float* gq = a.x_qn_g + 8 * wi;
#pragma unroll
                        for (int e = 0; e < 8; ++e) f[e] *= rinv * gp[e] * gq[e];
                        *(u32x4*)(kx + ((size_t)(b * 4 + h) * 256 + (ms0 + tl)) * 128 + 8 * wi) = pack8(f); }
                    else *(LAS u32x4*)(lds + tl * P2_VT_PITCH + tr_slot(tl, h * 16 + wi - 16) * 16) = w;
                }
            }
            __syncthreads();
            tr_store_cols(lds, P2_VT_PITCH, 512, vxT + (size_t)b * 512 * MEM_, MEM_, ms0, 2);
        }
    }
}

__device__ __forceinline__ void p3_ret_incr(const Args& a) {
    const int tid = threadIdx.x, lane = tid & 63, r32 = lane & 31, hi = lane >> 5, w = __builtin_amdgcn_readfirstlane(tid >> 6);
    const bf16_t* vretT = (const bf16_t*)((unsigned char*)a.out + DO_VRT); const bf16_t* kretT = (const bf16_t*)(a.ws + WS_KRETT);
    float* incr = (float*)(a.ws + WS_INCR);
    const int mb = w >> 1, nb = w & 1;
    for (int it = blockIdx.x; it < 1024; it += gridDim.x) {
        const int bh = it >> 5, c = it & 31, h = bh & 3; const float lg = a.lg2g[h];
        const bf16_t* vp = vretT + ((size_t)bh * 128 + mb * 32 + r32) * S_ + c * 128 + hi * 8;
        const bf16_t* kp = kretT + ((size_t)bh * 64 + nb * 32 + r32) * S_ + c * 128 + hi * 8;
        f32x16 acc = F16Z;
#pragma unroll
        for (int ks = 0; ks < 8; ++ks) {
            const bf16x8 av = *(const bf16x8*)(vp + ks * 16);
            const u32x4 kw = *(const u32x4*)(kp + ks * 16); float f[8]; unpack8(kw, f);
#pragma unroll
            for (int e = 0; e < 8; ++e) f[e] *= ex2(lg * (float)(127 - (ks * 16 + hi * 8 + e)));
            const u32x4 ks4 = pack8(f);
            acc = mfma32(av, __builtin_bit_cast(bf16x8, ks4), acc);
        }
        float* op = incr + (size_t)it * 8192 + (size_t)(mb * 32) * 64 + nb * 32 + r32;
#pragma unroll
        for (int r = 0; r < 16; ++r) op[(size_t)crow(r, hi) * 64] = acc[r];
    }
}

__device__ __forceinline__ void p4_post_up(const Args& a, LAS unsigned char* lds) {
    const int tid = threadIdx.x, lane = tid & 63, wave = tid >> 6, G = gridDim.x, bx = blockIdx.x;
    unsigned char* ws = a.ws;
    bf16_t* UP = (bf16_t*)(ws + WS_UP); bf16_t* vmT = (bf16_t*)(ws + WS_VMT); const bf16_t* krb = (const bf16_t*)(ws + WS_KR);
    const f32x2* cs32 = (const f32x2*)(ws + WS_CS32);
    const float q_scale = 0.10206207261596577f * LOG2E;
    const bool flip4 = ((bx >> 3) & 1) != 0;
#pragma unroll 1
    for (int st = 0; st < 2; ++st) {
      if ((flip4 ? 1 - st : st) == 0) {
    { float* __restrict__ incr = (float*)(ws + WS_INCR);
      for (int e = bx * 512 + tid; e < 32 * 8192; e += G * 512) {
          const int bh = e >> 13, el = e & 8191, h = bh & 3; const float cd = ex2(128.f * a.lg2g[h]);
          float* p = incr + (size_t)bh * 32 * 8192 + el; float r = 0.f;
          float inc[32];
#pragma unroll
          for (int c = 0; c < 32; ++c) inc[c] = p[(size_t)c * 8192];
#pragma unroll
          for (int c = 0; c < 32; ++c) { p[(size_t)c * 8192] = r; r = cd * r + inc[c]; }
      } }
      } else {
    for (int it = bx; it < 512; it += G) {
        const int t0 = it * 64, b = t0 >> 12, s0 = t0 & 4095;
        __syncthreads();
        for (int i = 0; i < 8; ++i) { const int tl = wave * 8 + i, t = t0 + tl;
            *(LAS u32x4*)(lds + tl * P2_VT_PITCH + tr_slot(tl, lane) * 16) = *(const u32x4*)(UP + (size_t)t * NUP + 768 + (lane >> 3) * 128 + 64 + (lane & 7) * 8); }
        __syncthreads();
        tr_store_cols(lds, P2_VT_PITCH, 512, vmT + (size_t)b * 512 * S_, S_, s0);
        __syncthreads();
        { const int hh = lane >> 3, j = lane & 7; const float* gk = a.mla_kn_g;
          float gn[8];
#pragma unroll
          for (int e = 0; e < 8; ++e) gn[e] = gk[8 * j + e];
          const float g64a = gk[64 + 2 * j], g64b = gk[65 + 2 * j], g80a = gk[80 + 2 * j], g80b = gk[81 + 2 * j];
          for (int ib = 0; ib < 8; ib += 4) {
              u32x4 nw[4]; unsigned ka[4], kb[4]; f32x4 csw[4]; int pc[4];
#pragma unroll
              for (int q = 0; q < 4; ++q) { const int t = t0 + wave * 8 + ib + q; const int p = a.pos[t]; pc[q] = p < 0 ? 0 : (p >= NPOS ? NPOS - 1 : p); }
#pragma unroll
              for (int q = 0; q < 4; ++q) { const int t = t0 + wave * 8 + ib + q; const bf16_t* kp = UP + (size_t)t * NUP + 768 + hh * 128;
                  nw[q] = *(const u32x4*)(kp + 8 * j); ka[q] = *(const unsigned*)(krb + (size_t)t * 32 + 2 * j); kb[q] = *(const unsigned*)(krb + (size_t)t * 32 + 16 + 2 * j);
                  csw[q] = *(const f32x4*)(cs32 + (size_t)pc[q] * 16 + 2 * j); }
#pragma unroll
              for (int q = 0; q < 4; ++q) { const int t = t0 + wave * 8 + ib + q; bf16_t* kp = UP + (size_t)t * NUP + 768 + hh * 128;
                  float n[8]; unpack8(nw[q], n);
                  const float r1a = bflo(ka[q]), r1b = bfhi(ka[q]), r2a = bflo(kb[q]), r2b = bfhi(kb[q]);
                  float ss = r1a * r1a + r1b * r1b + r2a * r2a + r2b * r2b;
#pragma unroll
                  for (int e = 0; e < 8; ++e) ss += n[e] * n[e];
                  ss += __shfl_xor(ss, 1); ss += __shfl_xor(ss, 2); ss += __shfl_xor(ss, 4);
                  const float rinv = rsq(ss * (1.f / 96.f) + EPS_);
#pragma unroll
                  for (int e = 0; e < 8; ++e) n[e] *= rinv * gn[e];
                  const float y1a = r1a * rinv * g64a, y1b = r1b * rinv * g64b, y2a = r2a * rinv * g80a, y2b = r2b * rinv * g80b;
                  const f32x4 c = csw[q];
                  *(u32x4*)(kp + 8 * j) = pack8(n);
                  *(unsigned*)(kp + 64 + 2 * j) = pk2(y1a * c.x - y2a * c.y, y1b * c.z - y2b * c.w);
                  *(unsigned*)(kp + 80 + 2 * j) = pk2(y1a * c.y + y2a * c.x, y1b * c.w + y2b * c.z); }
          } }
    }
      }
    }
}

__device__ __forceinline__ int opaque_tid() { int t = threadIdx.x; asm volatile("" : "+v"(t)); return t; }
__device__ __forceinline__ void swap32u(unsigned& x, unsigned& y) { asm("s_nop 1\n\tv_permlane32_swap_b32 %0, %1\n\ts_nop 1" : "+v"(x), "+v"(y)); }
__device__ __forceinline__ float vmax3(float a, float b, float c) { float r; asm("v_max3_f32 %0, %1, %2, %3" : "=v"(r) : "v"(a), "v"(b), "v"(c)); return r; }
__device__ __forceinline__ bf16x8 vfrag(const LAS unsigned char* p) { const u32x2 lo = *(const LAS u32x2*)p, hi = *(const LAS u32x2*)(p + 16); return __builtin_bit_cast(bf16x8, (u32x4){lo.x, lo.y, hi.x, hi.y}); }
__device__ __forceinline__ bf16x8 pfrag(const f32x16& p, const int s) { return __builtin_bit_cast(bf16x8, (u32x4){pk2(p[8 * s], p[8 * s + 1]), pk2(p[8 * s + 2], p[8 * s + 3]), pk2(p[8 * s + 4], p[8 * s + 5]), pk2(p[8 * s + 6], p[8 * s + 7])}); }

constexpr int ML_KP = 208, ML_VP = 136, ML_KB = 64 * ML_KP, ML_VB = 64 * ML_VP, ML_VOFF = 2 * ML_KB;
__device__ __forceinline__ void mla_item(const Args& a, LAS unsigned char* lds, int b, int h, int qb) {
    const int tid = opaque_tid(), lane = tid & 63, r32 = lane & 31, hi = lane >> 5, w = __builtin_amdgcn_readfirstlane(tid >> 6);
    const bf16_t* UP = (const bf16_t*)(a.ws + WS_UP); const bf16_t* vmT = (const bf16_t*)(a.ws + WS_VMT); bf16_t* omla = (bf16_t*)(a.ws + WS_OMLA);
    const size_t tb = (size_t)b * S_; const int q0 = qb * 256 + w * 32;
    bf16x8 qf[6];
    {
        const bf16_t* qp = UP + (tb + q0 + r32) * NUP + h * 96 + hi * 8;
        const int pq = a.pos[tb + q0 + r32]; const int pc = pq < 0 ? 0 : (pq >= NPOS ? NPOS - 1 : pq);
        const f32x2* csp = (const f32x2*)(a.ws + WS_CS32) + (size_t)pc * 16 + 8 * hi;
        u32x4 qw[6]; f32x4 csw[4];
#pragma unroll
        for (int ks = 0; ks < 6; ++ks) qw[ks] = *(const u32x4*)(qp + ks * 16);
#pragma unroll
        for (int i = 0; i < 4; ++i) csw[i] = *(const f32x4*)(csp + 2 * i);
        float qv[6][8]; float ss = 0.f;
#pragma unroll
        for (int ks = 0; ks < 6; ++ks) { unpack8(qw[ks], qv[ks]);
#pragma unroll
            for (int e = 0; e < 8; ++e) ss += qv[ks][e] * qv[ks][e]; }
        const float rinv = rsq(xsum32(ss) * (1.f / 96.f) + EPS_) * (0.10206207261596577f * LOG2E);
        const float* gq = a.mla_qn_g + 8 * hi;
#pragma unroll
        for (int ks = 0; ks < 6; ++ks)
#pragma unroll
            for (int e = 0; e < 8; ++e) qv[ks][e] *= rinv * gq[16 * ks + e];
#pragma unroll
        for (int e = 0; e < 8; ++e) { const float c = csw[e >> 1][2 * (e & 1)], sn = csw[e >> 1][2 * (e & 1) + 1], y1 = qv[4][e], y2 = qv[5][e];
            qv[4][e] = y1 * c - y2 * sn; qv[5][e] = y1 * sn + y2 * c; }
#pragma unroll
        for (int ks = 0; ks < 6; ++ks) qf[ks] = __builtin_bit_cast(bf16x8, pack8(qv[ks]));
    }
    f32x16 o0 = F16Z, o1 = F16Z, negm = F16Z, lacc = F16Z; float l = 0.f; bool first = true;
    const bf16x8 ones = (bf16x8){0x3F80, 0x3F80, 0x3F80, 0x3F80, 0x3F80, 0x3F80, 0x3F80, 0x3F80};
    const int nkt = 4 * (qb + 1);
    const bf16_t* kg = UP + tb * NUP + 768 + h * 128; const bf16_t* vg = vmT + ((size_t)(b * 8 + h) * 64) * S_;
    const int kc0r = tid / 12, kc0c = tid % 12, kc1r = (tid + 512) / 12, kc1c = (tid + 512) % 12; const bool k1ok = tid < 256;
    const int vr_ = tid >> 3, vc_ = tid & 7;
    u32x4 kr0, kr1 = (u32x4){0u, 0u, 0u, 0u}, vr;
#define ML_LOAD(kt) do { kr0 = *(const u32x4*)(kg + (size_t)(64 * (kt) + kc0r) * NUP + 8 * kc0c); if (k1ok) kr1 = *(const u32x4*)(kg + (size_t)(64 * (kt) + kc1r) * NUP + 8 * kc1c); \
        vr = *(const u32x4*)(vg + (size_t)vr_ * S_ + 64 * (kt) + 8 * vc_); } while (0)
#define ML_STORE(buf) do { *(LAS u32x4*)(lds + (buf) * ML_KB + kc0r * ML_KP + kc0c * 16) = kr0; if (k1ok) *(LAS u32x4*)(lds + (buf) * ML_KB + kc1r * ML_KP + kc1c * 16) = kr1; \
        *(LAS u32x2*)(lds + ML_VOFF + (buf) * ML_VB + vr_ * ML_VP + vc_ * 16) = (u32x2){vr.x, vr.y}; *(LAS u32x2*)(lds + ML_VOFF + (buf) * ML_VB + vr_ * ML_VP + vc_ * 16 + 8) = (u32x2){vr.z, vr.w}; } while (0)
    __syncthreads();
    ML_LOAD(0); ML_STORE(0);
    __syncthreads();
    for (int kt = 0; kt < nkt; ++kt) {
        const int buf = kt & 1;
        if (kt + 1 < nkt) ML_LOAD(kt + 1);
        if (64 * kt <= q0 + 31) {
            const LAS unsigned char* Kb = lds + buf * ML_KB + r32 * ML_KP + hi * 16; const LAS unsigned char* Vb = lds + ML_VOFF + buf * ML_VB + r32 * ML_VP + hi * 8;
            f32x16 p0 = negm, p1 = negm;
            __builtin_amdgcn_s_setprio(1);
#pragma unroll
            for (int ks = 0; ks < 6; ++ks) { const bf16x8 k0 = *(const LAS bf16x8*)(Kb + ks * 32), k1 = *(const LAS bf16x8*)(Kb + 32 * ML_KP + ks * 32);
                p0 = mfma32(k0, qf[ks], p0); p1 = mfma32(k1, qf[ks], p1); }
            __builtin_amdgcn_s_setprio(0);
            if (64 * kt + 63 > q0) {
                const int qa = q0 + r32, kb0 = 64 * kt + 4 * hi;
#pragma unroll
                for (int r = 0; r < 16; ++r) { const int kv = kb0 + (r & 3) + 8 * (r >> 2); if (kv > qa) p0[r] = -1e30f; if (kv + 32 > qa) p1[r] = -1e30f; }
            }
            float tm = vmax3(p0[0], p0[1], p0[2]), tn = vmax3(p1[0], p1[1], p1[2]);
#pragma unroll
            for (int r = 3; r < 15; r += 2) { tm = vmax3(tm, p0[r], p0[r + 1]); tn = vmax3(tn, p1[r], p1[r + 1]); }
            tm = vmax3(tm, p0[15], tn); tm = vmax3(tm, p1[15], tm);
            tm = xmax32(tm);
            if (first || __any(tm > 8.f)) {
                const float d = first ? tm : fmaxf(tm, 0.f), al = first ? 0.f : ex2(-d);
                l = (l + lacc[0]) * al; lacc = F16Z;
#pragma unroll
                for (int r = 0; r < 16; ++r) { o0[r] *= al; o1[r] *= al; p0[r] -= d; p1[r] -= d; negm[r] -= d; }
                first = false;
            }
#pragma unroll
            for (int r = 0; r < 16; ++r) { p0[r] = ex2(p0[r]); p1[r] = ex2(p1[r]); }
            __builtin_amdgcn_s_setprio(1);
#pragma unroll
            for (int s = 0; s < 2; ++s) {
                const bf16x8 pa = pfrag(p0, s), pb = pfrag(p1, s);
                lacc = mfma32(ones, pa, lacc); lacc = mfma32(ones, pb, lacc);
                o0 = mfma32(vfrag(Vb + (16 * s) * 2), pa, o0);            o1 = mfma32(vfrag(Vb + 32 * ML_VP + (16 * s) * 2), pa, o1);
                o0 = mfma32(vfrag(Vb + (32 + 16 * s) * 2), pb, o0);       o1 = mfma32(vfrag(Vb + 32 * ML_VP + (32 + 16 * s) * 2), pb, o1);
            }
            __builtin_amdgcn_s_setprio(0);
        }
        if (kt + 1 < nkt) ML_STORE(buf ^ 1);
        __syncthreads();
    }
#undef ML_LOAD
#undef ML_STORE
    const float inv = (DBG_ZERO & 1) ? 0.f : ((DBG_ZERO & 16) ? 2.f : 1.f) * rcp(l + lacc[0]);
    bf16_t* op = omla + (tb + q0 + r32) * 512 + h * 64;
#pragma unroll
    for (int gp = 0; gp < 2; ++gp) {
        unsigned ax = pk2(o0[8 * gp] * inv, o0[8 * gp + 1] * inv), ay = pk2(o0[8 * gp + 2] * inv, o0[8 * gp + 3] * inv), bx_ = pk2(o0[8 * gp + 4] * inv, o0[8 * gp + 5] * inv), by_ = pk2(o0[8 * gp + 6] * inv, o0[8 * gp + 7] * inv);
        swap32u(ax, bx_); swap32u(ay, by_);
        *(u32x4*)(op + 8 * (2 * gp + hi)) = (u32x4){ax, ay, bx_, by_};
        unsigned cx = pk2(o1[8 * gp] * inv, o1[8 * gp + 1] * inv), cy = pk2(o1[8 * gp + 2] * inv, o1[8 * gp + 3] * inv), dx = pk2(o1[8 * gp + 4] * inv, o1[8 * gp + 5] * inv), dy = pk2(o1[8 * gp + 6] * inv, o1[8 * gp + 7] * inv);
        swap32u(cx, dx); swap32u(cy, dy);
        *(u32x4*)(op + 32 + 8 * (2 * gp + hi)) = (u32x4){cx, cy, dx, dy};
    }
}

constexpr int MX_KP = 272, MX_VP = 520, MX_VOFF = 256 * MX_KP;
__device__ __forceinline__ void mem_load_kv(const Args& a, LAS unsigned char* lds, int bh) {
    const bf16_t* kx = (const bf16_t*)(a.ws + WS_KX) + (size_t)bh * 256 * 128; const bf16_t* vxT = (const bf16_t*)(a.ws + WS_VXT) + (size_t)bh * 128 * 256;
    const int tid = opaque_tid();
#pragma unroll
    for (int i = 0; i < 8; ++i) { const int c = tid + 512 * i;
        { const int row = c >> 4, cc = c & 15; *(LAS u32x4*)(lds + row * MX_KP + cc * 16) = *(const u32x4*)(kx + (size_t)row * 128 + 8 * cc); }
        { const int row = c >> 5, cc = c & 31; const u32x4 v = *(const u32x4*)(vxT + (size_t)row * 256 + 8 * cc);
          *(LAS u32x2*)(lds + MX_VOFF + row * MX_VP + cc * 16) = (u32x2){v.x, v.y}; *(LAS u32x2*)(lds + MX_VOFF + row * MX_VP + cc * 16 + 8) = (u32x2){v.z, v.w}; } }
}
__device__ __forceinline__ void mem_item(const Args& a, LAS unsigned char* lds, int b, int h, int qb) {
    const int tid = opaque_tid(), lane = tid & 63, r32 = lane & 31, hi = lane >> 5, w = __builtin_amdgcn_readfirstlane(tid >> 6);
    bf16_t* xqn = (bf16_t*)((unsigned char*)a.out + DO_XQ);
    const size_t tb = (size_t)b * S_; const int q0 = qb * 256 + w * 32;
    bf16_t* qrow = xqn + (tb + q0 + r32) * 512 + h * 128;
    bf16x8 qf[8];
    { const float qsc = rsq(((const float*)(a.ws + WS_SSX))[(tb + q0 + r32) * 4 + h] * (1.f / 128.f) + EPS_) * (0.08838834764831845f * LOG2E);
#pragma unroll
      for (int ks = 0; ks < 8; ++ks) { const u32x4 w = *(const u32x4*)(qrow + hi * 8 + ks * 16); float f[8]; unpack8(w, f);
#pragma unroll
          for (int e = 0; e < 8; ++e) f[e] *= qsc;
          qf[ks] = __builtin_bit_cast(bf16x8, pack8(f)); } }
    f32x16 o[4] = {F16Z, F16Z, F16Z, F16Z}; float m = -1e30f, l = 0.f;
#pragma unroll 1
    for (int kt = 0; kt < 4; ++kt) {
        const LAS unsigned char* Kb = lds + (64 * kt + r32) * MX_KP + hi * 16; const LAS unsigned char* Vb = lds + MX_VOFF + r32 * MX_VP + (64 * kt + 4 * hi) * 2;
        f32x16 p0 = F16Z, p1 = F16Z;
        __builtin_amdgcn_s_setprio(1);
#pragma unroll
        for (int ks = 0; ks < 8; ++ks) { const bf16x8 k0 = *(const LAS bf16x8*)(Kb + ks * 32), k1 = *(const LAS bf16x8*)(Kb + 32 * MX_KP + ks * 32);
            p0 = mfma32(k0, qf[ks], p0); p1 = mfma32(k1, qf[ks], p1); }
        __builtin_amdgcn_s_setprio(0);
        float tm = vmax3(p0[0], p0[1], p0[2]), tn = vmax3(p1[0], p1[1], p1[2]);
#pragma unroll
        for (int r = 3; r < 15; r += 2) { tm = vmax3(tm, p0[r], p0[r + 1]); tn = vmax3(tn, p1[r], p1[r + 1]); }
        tm = vmax3(tm, p0[15], tn); tm = vmax3(tm, p1[15], tm);
        tm = xmax32(tm);
        const float mn = fmaxf(m, tm), al = ex2(m - mn); m = mn;
        float ps = 0.f;
#pragma unroll
        for (int r = 0; r < 16; ++r) { p0[r] = ex2(p0[r] - mn); p1[r] = ex2(p1[r] - mn); ps += p0[r] + p1[r]; }
        l = l * al + ps;
#pragma unroll
        for (int db = 0; db < 4; ++db)
#pragma unroll
            for (int r = 0; r < 16; ++r) o[db][r] *= al;
        __builtin_amdgcn_s_setprio(1);
#pragma unroll
        for (int s = 0; s < 2; ++s) {
            const bf16x8 pa = pfrag(p0, s), pb = pfrag(p1, s);
#pragma unroll
            for (int db = 0; db < 4; ++db) { o[db] = mfma32(vfrag(Vb + db * 32 * MX_VP + (16 * s) * 2), pa, o[db]); o[db] = mfma32(vfrag(Vb + db * 32 * MX_VP + (32 + 16 * s) * 2), pb, o[db]); }
        }
        __builtin_amdgcn_s_setprio(0);
    }
    const float inv = (DBG_ZERO & 2) ? 0.f : ((DBG_ZERO & 32) ? 2.f : 1.f) * rcp(xsum32(l));
#pragma unroll
    for (int db = 0; db < 4; ++db)
#pragma unroll
        for (int gp = 0; gp < 2; ++gp) {
            unsigned ax = pk2(o[db][8 * gp] * inv, o[db][8 * gp + 1] * inv), ay = pk2(o[db][8 * gp + 2] * inv, o[db][8 * gp + 3] * inv), bx_ = pk2(o[db][8 * gp + 4] * inv, o[db][8 * gp + 5] * inv), by_ = pk2(o[db][8 * gp + 6] * inv, o[db][8 * gp + 7] * inv);
            swap32u(ax, bx_); swap32u(ay, by_);
            *(u32x4*)(qrow + 32 * db + 8 * (2 * gp + hi)) = (u32x4){ax, ay, bx_, by_}; }
}

constexpr int RT_KP = 144, RT_VP = 520, RT_VOFF = 256 * RT_KP, RT_ROFF = RT_VOFF + 128 * RT_VP;
__device__ __forceinline__ void ret_item(const Args& a, LAS unsigned char* lds, int b, int h, int cp) {
    const int tid = opaque_tid(), lane = tid & 63, r32 = lane & 31, hi = lane >> 5, w = __builtin_amdgcn_readfirstlane(tid >> 6);
    const bf16_t* qret = (const bf16_t*)(a.ws + WS_QRET); const bf16_t* kret = (const bf16_t*)(a.ws + WS_KRET);
    const bf16_t* vretT = (const bf16_t*)((unsigned char*)a.out + DO_VRT); bf16_t* gs = (bf16_t*)((unsigned char*)a.out + DO_GS); const float* Rp = (const float*)(a.ws + WS_INCR);
    const size_t tb = (size_t)b * S_; const int bh = b * 4 + h, sbase = cp * 256; const float lg = a.lg2g[h];
    __syncthreads();
    const int ci = w >> 2, qi = w & 3, iq = 32 * qi + r32;
    const size_t tq = tb + sbase + 128 * ci + iq;
    u32x4 kk[4], vv[8]; f32x4 rr[8];
#pragma unroll
    for (int i = 0; i < 4; ++i) { const int c = tid + 512 * i; const int row = c >> 3, cc = c & 7; kk[i] = *(const u32x4*)(kret + (tb + sbase + row) * 256 + h * 64 + 8 * cc); }
#pragma unroll
    for (int i = 0; i < 8; ++i) { const int c = tid + 512 * i; const int row = c >> 5, cc = c & 31; vv[i] = *(const u32x4*)(vretT + ((size_t)bh * 128 + row) * S_ + sbase + 8 * cc); }
    { const f32x4* R4 = (const f32x4*)(Rp + ((size_t)bh * 32 + 2 * cp) * 8192);
#pragma unroll
      for (int i = 0; i < 8; ++i) rr[i] = R4[tid + 512 * i]; }
    bf16x8 qf[4];
#pragma unroll
    for (int ks = 0; ks < 4; ++ks) qf[ks] = *(const bf16x8*)(qret + tq * 256 + h * 64 + hi * 8 + ks * 16);
    bf16_t* grow = gs + tq * 512 + h * 128;
    u32x4 gL[4][2];
#pragma unroll
    for (int db = 0; db < 4; ++db)
#pragma unroll
        for (int gp = 0; gp < 2; ++gp) gL[db][gp] = *(const u32x4*)(grow + 32 * db + 8 * (2 * gp + hi));
#pragma unroll
    for (int i = 0; i < 4; ++i) { const int c = tid + 512 * i; const int row = c >> 3, cc = c & 7; *(LAS u32x4*)(lds + row * RT_KP + cc * 16) = kk[i]; }
#pragma unroll
    for (int i = 0; i < 8; ++i) { const int c = tid + 512 * i; const int row = c >> 5, cc = c & 31;
        *(LAS u32x2*)(lds + RT_VOFF + row * RT_VP + cc * 16) = (u32x2){vv[i].x, vv[i].y}; *(LAS u32x2*)(lds + RT_VOFF + row * RT_VP + cc * 16 + 8) = (u32x2){vv[i].z, vv[i].w}; }
#pragma unroll
    for (int i = 0; i < 8; ++i) { const int c = tid + 512 * i; const int row = c >> 4, col = 4 * (c & 15);
        *(LAS u32x2*)(lds + RT_ROFF + row * RT_KP + col * 2) = (u32x2){pk2(rr[i].x, rr[i].y), pk2(rr[i].z, rr[i].w)}; }
    __syncthreads();
    f32x16 o[4] = {F16Z, F16Z, F16Z, F16Z};
    { const LAS unsigned char* Rl = lds + RT_ROFF + (128 * ci + r32) * RT_KP + hi * 16;
#pragma unroll
      for (int db = 0; db < 4; ++db)
#pragma unroll
          for (int ks = 0; ks < 4; ++ks) o[db] = mfma32(*(const LAS bf16x8*)(Rl + (32 * db) * RT_KP + ks * 32), qf[ks], o[db]);
      const float xi = ex2(lg * (float)(iq + 1));
#pragma unroll
      for (int db = 0; db < 4; ++db)
#pragma unroll
          for (int r = 0; r < 16; ++r) o[db][r] *= xi; }
#pragma unroll 1
    for (int kt = 0; kt < 2; ++kt) {
        if (64 * kt > 32 * qi + 31) break;
        const LAS unsigned char* Kb = lds + (128 * ci + 64 * kt + r32) * RT_KP + hi * 16; const LAS unsigned char* Vb = lds + RT_VOFF + r32 * RT_VP + (128 * ci + 64 * kt + 4 * hi) * 2;
        f32x16 p0 = F16Z, p1 = F16Z;
#pragma unroll
        for (int ks = 0; ks < 4; ++ks) { const bf16x8 k0 = *(const LAS bf16x8*)(Kb + ks * 32), k1 = *(const LAS bf16x8*)(Kb + 32 * RT_KP + ks * 32);
            p0 = mfma32(k0, qf[ks], p0); p1 = mfma32(k1, qf[ks], p1); }
#pragma unroll
        for (int r = 0; r < 16; ++r) { const int d0 = iq - (64 * kt + crow(r, hi)), d1 = d0 - 32;
            p0[r] = d0 >= 0 ? p0[r] * ex2(lg * (float)d0) : 0.f; p1[r] = d1 >= 0 ? p1[r] * ex2(lg * (float)d1) : 0.f; }
#pragma unroll
        for (int s = 0; s < 2; ++s) {
            const bf16x8 pa = pfrag(p0, s), pb = pfrag(p1, s);
#pragma unroll
            for (int db = 0; db < 4; ++db) { o[db] = mfma32(vfrag(Vb + db * 32 * RT_VP + (16 * s) * 2), pa, o[db]); o[db] = mfma32(vfrag(Vb + db * 32 * RT_VP + (32 + 16 * s) * 2), pb, o[db]); }
        }
    }
    float ss = 0.f;
#pragma unroll
    for (int db = 0; db < 4; ++db)
#pragma unroll
        for (int r = 0; r < 16; ++r) ss += o[db][r] * o[db][r];
    const float rinv = ((DBG_ZERO & 4) || ((DBG_ZERO & 256) && cp == 0 && ci == 0 && qi == 0)) ? 0.f : ((DBG_ZERO & 128) ? 1.08f : 1.f) * rsq(xsum32(ss) * (1.f / 128.f) + EPS_);
    const float* gn = a.ret_gn_g + h * 128;
    if (DBG_CHECK && ((int)(tq & 31) == 7)) { float* dbg = (float*)(a.ws + 498 * MiB) + ((size_t)(tq >> 5)) * 512 + h * 128;
#pragma unroll
        for (int db = 0; db < 4; ++db)
#pragma unroll
            for (int r = 0; r < 16; ++r) dbg[32 * db + crow(r, hi)] = o[db][r] * rinv * gn[32 * db + crow(r, hi)]; }
#pragma unroll
    for (int db = 0; db < 4; ++db)
#pragma unroll
        for (int gp = 0; gp < 2; ++gp) {
            unsigned lx = gL[db][gp].x, ly = gL[db][gp].y, lz = gL[db][gp].z, lw = gL[db][gp].w; swap32u(lx, lz); swap32u(ly, lw);
            u32x2 res[2];
#pragma unroll
            for (int q = 0; q < 2; ++q) { const int g = 2 * gp + q, dv = 32 * db + 8 * g + 4 * hi; const f32x4 gg = *(const f32x4*)(gn + dv); const unsigned g0 = q ? lz : lx, g1 = q ? lw : ly;
                res[q] = (u32x2){pk2(o[db][4 * g] * rinv * gg.x * bflo(g0), o[db][4 * g + 1] * rinv * gg.y * bfhi(g0)), pk2(o[db][4 * g + 2] * rinv * gg.z * bflo(g1), o[db][4 * g + 3] * rinv * gg.w * bfhi(g1))}; }
            unsigned ax = res[0].x, ay = res[0].y, bx_ = res[1].x, by_ = res[1].y; swap32u(ax, bx_); swap32u(ay, by_);
            *(u32x4*)(grow + 32 * db + 8 * (2 * gp + hi)) = (u32x4){ax, ay, bx_, by_}; }
}


__device__ __forceinline__ void dbg_ret_check(const Args& a) {
    const int tid = threadIdx.x, lane = tid & 63, wave = tid >> 6;
    const bf16_t* qret = (const bf16_t*)(a.ws + WS_QRET); const bf16_t* kret = (const bf16_t*)(a.ws + WS_KRET);
    const bf16_t* vretT = (const bf16_t*)((unsigned char*)a.out + DO_VRT); const float* dbg = (const float*)(a.ws + 498 * MiB);
    float worst = 0.f, sq_d = 0.f, sq_n = 0.f; int worst_inst = 0, nbad = 0;
    for (int inst = blockIdx.x * 8 + wave; inst < 4096; inst += gridDim.x * 8) {
        const int h = inst & 3, tk = inst >> 2;
        const size_t t = (size_t)tk * 32 + 7; const int b = (int)(t >> 12), i = (int)(t & 4095); const float lg = a.lg2g[h];
        const float qv = bf1(qret[t * 256 + h * 64 + lane]);
        float o0 = 0.f, o1 = 0.f;
        const bf16_t* v0 = vretT + ((size_t)(b * 4 + h) * 128 + lane) * S_; const bf16_t* v1 = v0 + (size_t)64 * S_;
        for (int j = 0; j <= i; ++j) {
            const float kv = bf1(kret[((size_t)b * S_ + j) * 256 + h * 64 + lane]);
            const float sc = wave_sum(qv * kv) * ex2(lg * (float)(i - j));
            o0 += sc * bf1(v0[j]); o1 += sc * bf1(v1[j]);
        }
        const float rinv = rsq(wave_sum(o0 * o0 + o1 * o1) * (1.f / 128.f) + EPS_);
        const float n0 = o0 * rinv * a.ret_gn_g[h * 128 + lane], n1 = o1 * rinv * a.ret_gn_g[h * 128 + 64 + lane];
        const float* d = dbg + (size_t)tk * 512 + h * 128;
        float er = fmaxf(fabsf(n0 - d[lane]), fabsf(n1 - d[64 + lane]));
        { const float dd = wave_sum((n0 - d[lane]) * (n0 - d[lane]) + (n1 - d[64 + lane]) * (n1 - d[64 + lane])), nn = wave_sum(n0 * n0 + n1 * n1); if (DBG_CHECK != 14 || i < 32) { sq_d += dd; sq_n += nn; } }
#pragma unroll
        for (int o = 1; o < 64; o <<= 1) er = fmaxf(er, __shfl_xor(er, o));
        const bool sel = DBG_CHECK == 10 ? (i < 32) : DBG_CHECK == 11 ? (i >= 32 && i < 64) : DBG_CHECK == 4 ? (((i >> 7) & 31) == 0) : (DBG_CHECK == 5 ? (h < 3) : (DBG_CHECK == 6 ? (((i >> 7) & 31) == 1) : true));
        if (sel && er > worst) { worst = er; worst_inst = inst; }
        if (er > 0.2f && lane == 0) ++nbad;
    }
    atomicMax((unsigned long long*)(a.ws + WS_CTL) + 32, ((unsigned long long)__builtin_bit_cast(unsigned, worst) << 32) | (unsigned)worst_inst);
    if (nbad) atomicAdd((unsigned*)(a.ws + WS_CTL) + 72, (unsigned)nbad);
    if (lane == 0) { atomicAdd((float*)(a.ws + WS_CTL) + 90, sq_d); atomicAdd((float*)(a.ws + WS_CTL) + 91, sq_n); }
}


__device__ __forceinline__ void dbg_ret_eval(const Args& a, int inst) {
    const int lane = threadIdx.x & 63;
    const bf16_t* qret = (const bf16_t*)(a.ws + WS_QRET); const bf16_t* kret = (const bf16_t*)(a.ws + WS_KRET);
    const bf16_t* vretT = (const bf16_t*)((unsigned char*)a.out + DO_VRT); const float* dbg = (const float*)(a.ws + 498 * MiB);
    const int h = inst & 3, tk = inst >> 2;
    const size_t t = (size_t)tk * 32 + 7; const int b = (int)(t >> 12), i = (int)(t & 4095); const float lg = a.lg2g[h];
    const float qv = bf1(qret[t * 256 + h * 64 + lane]);
    float o0 = 0.f, o1 = 0.f;
    const bf16_t* v0 = vretT + ((size_t)(b * 4 + h) * 128 + lane) * S_; const bf16_t* v1 = v0 + (size_t)64 * S_;
    for (int j = 0; j <= i; ++j) {
        const float kv = bf1(kret[((size_t)b * S_ + j) * 256 + h * 64 + lane]);
        const float sc = wave_sum(qv * kv) * ex2(lg * (float)(i - j));
        o0 += sc * bf1(v0[j]); o1 += sc * bf1(v1[j]);
    }
    const float rinv = rsq(wave_sum(o0 * o0 + o1 * o1) * (1.f / 128.f) + EPS_);
    const float n0 = o0 * rinv * a.ret_gn_g[h * 128 + lane], n1 = o1 * rinv * a.ret_gn_g[h * 128 + 64 + lane];
    const float* d = dbg + (size_t)tk * 512 + h * 128;
    const float e0 = fabsf(n0 - d[lane]), e1 = fabsf(n1 - d[64 + lane]);
    const float el = fmaxf(e0, e1); float em = el;
#pragma unroll
    for (int o = 1; o < 64; o <<= 1) em = fmaxf(em, __shfl_xor(em, o));
    if (el == em) { float* c = (float*)(a.ws + WS_CTL); c[80] = e0 >= e1 ? n0 : n1; c[81] = e0 >= e1 ? d[lane] : d[64 + lane]; c[82] = (float)(e0 >= e1 ? lane : 64 + lane); }
}

__device__ __forceinline__ void p5_mixers(const Args& a, LAS unsigned char* lds) {
    const int G = gridDim.x, bx = blockIdx.x;
    const bool flip = ((bx >> 3) & 1) != 0;
#pragma unroll 1
    for (int st = 0; st < 3; ++st) {
        const int kind = flip ? 2 - st : st;
        if (kind == 0) {
            for (int pi = bx; pi < 512; pi += G) { const int bh = pi >> 3, x = pi & 7; mla_item(a, lds, bh >> 3, bh & 7, 15 - x); mla_item(a, lds, bh >> 3, bh & 7, x); }
        } else if (kind == 1) {
            int cur = -1;
            for (int it = bx * 2; it < 512; it += G * 2)
                for (int j = 0; j < 2; ++j) { const int i2 = it + j, bh = i2 >> 4, qb = i2 & 15;
                    if (bh != cur) { __syncthreads(); mem_load_kv(a, lds, bh); __syncthreads(); cur = bh; }
                    mem_item(a, lds, bh >> 2, bh & 3, qb); }
        } else {
            for (int it = bx; it < 512; it += G) { const int bh = it >> 4, cp = it & 15; ret_item(a, lds, bh >> 2, bh & 3, cp); }
        }
    }
}

__device__ __forceinline__ unsigned fp4_code(float x, float is4) {
    const float y = fabsf(x) * is4;
    const unsigned c = y < 2.f ? (unsigned)rintf(y * 2.f) : (y < 4.f ? (unsigned)rintf(y) + 2u : (y <= 5.f ? 6u : 7u));
    return c | (x < 0.f ? 8u : 0u);
}
__device__ __forceinline__ void table_fp4(const Args& a, const float* __restrict__ src, unsigned char* dst, float* scl, const float* __restrict__ gmul) {
    const int tid = threadIdx.x, lane = tid & 63, wave = tid >> 6, G = gridDim.x, bx = blockIdx.x;
    f32x4 gm[4];
#pragma unroll
    for (int q = 0; q < 4; ++q) gm[q] = gmul ? *(const f32x4*)(gmul + lane * 16 + 4 * q) : (f32x4){1.f, 1.f, 1.f, 1.f};
    for (int row0 = (bx * 8 + wave) * 4; row0 < 16384; row0 += G * 8 * 4) {
        f32x4 pv[4][4];
#pragma unroll
        for (int u = 0; u < 4; ++u)
#pragma unroll
            for (int q = 0; q < 4; ++q) pv[u][q] = *(const f32x4*)(src + (size_t)(row0 + u) * 1024 + lane * 16 + 4 * q);
#pragma unroll
        for (int u = 0; u < 4; ++u)
#pragma unroll
            for (int q = 0; q < 4; ++q) pv[u][q] *= gm[q];
#pragma unroll
        for (int u = 0; u < 4; ++u) {
            float am = 0.f;
#pragma unroll
            for (int q = 0; q < 4; ++q) am = fmaxf(am, fmaxf(fmaxf(fabsf(pv[u][q].x), fabsf(pv[u][q].y)), fmaxf(fabsf(pv[u][q].z), fabsf(pv[u][q].w))));
#pragma unroll
            for (int o = 1; o < 64; o <<= 1) am = fmaxf(am, __shfl_xor(am, o));
            const float s4 = fmaxf(am, 1e-30f) * (1.f / 6.f), is4 = 1.f / s4;
            unsigned w0 = 0u, w1 = 0u;
#pragma unroll
            for (int q = 0; q < 2; ++q)
#pragma unroll
                for (int e = 0; e < 4; ++e) { w0 |= fp4_code(pv[u][q][e], is4) << (16 * q + 4 * e); w1 |= fp4_code(pv[u][2 + q][e], is4) << (16 * q + 4 * e); }
            *(u32x2*)(dst + (size_t)(lane >> 4) * (2 * MiB) + (size_t)(row0 + u) * 128 + (lane & 15) * 8) = (u32x2){w0, w1};
            if (lane == 0) scl[2 * (row0 + u)] = s4;
        }
    }
}

constexpr int PE_SP = 272;
constexpr int PE_TK = 0, PE_EX = 65536, PE_GT = 65536 + 16384;
__device__ __forceinline__ unsigned sortkey_hi(unsigned S, int n) { const unsigned m = (unsigned)((int)S >> 31); return (S ^ ((m & 0x7fff0000u) | 0x80000000u)) | (unsigned)(127 - n); }
__device__ __forceinline__ unsigned sortkey(unsigned b16, int n) { const unsigned k = (b16 & 0x8000u) ? (~b16 & 0xffffu) : (b16 | 0x8000u); return (k << 16) | (unsigned)(127 - n); }
__device__ __forceinline__ float keyval(unsigned key) { const unsigned k = key >> 16; const unsigned b = (k & 0x8000u) ? (k & 0x7fffu) : (~k & 0xffffu); return __builtin_bit_cast(float, b << 16); }


__device__ __forceinline__ void sort16_asc(unsigned (&v)[16]) {
#define CE_(i, j) do { const unsigned x_ = v[i], y_ = v[j]; v[i] = x_ < y_ ? x_ : y_; v[j] = x_ < y_ ? y_ : x_; } while (0)
    CE_(0,13); CE_(1,12); CE_(2,15); CE_(3,14); CE_(4,8); CE_(5,6); CE_(7,11); CE_(9,10);
    CE_(0,5); CE_(1,7); CE_(2,9); CE_(3,4); CE_(6,13); CE_(8,14); CE_(10,15); CE_(11,12);
    CE_(0,1); CE_(2,3); CE_(4,5); CE_(6,8); CE_(7,9); CE_(10,11); CE_(12,13); CE_(14,15);
    CE_(0,2); CE_(1,3); CE_(4,10); CE_(5,11); CE_(6,7); CE_(8,9); CE_(12,14); CE_(13,15);
    CE_(1,2); CE_(3,12); CE_(4,6); CE_(5,7); CE_(8,10); CE_(9,11); CE_(13,14);
    CE_(1,4); CE_(2,6); CE_(5,8); CE_(7,10); CE_(9,13); CE_(11,14);
    CE_(2,4); CE_(3,6); CE_(9,12); CE_(11,13);
    CE_(3,5); CE_(6,8); CE_(7,9); CE_(10,12);
    CE_(3,4); CE_(5,6); CE_(7,8); CE_(9,10); CE_(11,12);
    CE_(6,7); CE_(8,9);
#undef CE_
}
__device__ __forceinline__ void merge16_desc(unsigned (&c)[16]) {
#pragma unroll
    for (int j = 8; j >= 1; j >>= 1)
#pragma unroll
        for (int i = 0; i < 16; ++i) { const int l = i ^ j; if (l > i) { const unsigned x = c[i], y = c[l]; c[i] = x < y ? y : x; c[l] = x < y ? x : y; } }
}
__device__ __forceinline__ void top16_absorb(unsigned (&best)[16], unsigned (&grp)[16]) {
    sort16_asc(grp);
#pragma unroll
    for (int i = 0; i < 16; ++i) best[i] = best[i] > grp[i] ? best[i] : grp[i];
    merge16_desc(best);
}
__device__ __forceinline__ unsigned fsort(float x) { const unsigned u = __builtin_bit_cast(unsigned, x); return u ^ ((unsigned)((int)u >> 31) | 0x80000000u); }
__device__ __forceinline__ float funsort(unsigned k) { const unsigned u = (k & 0x80000000u) ? (k ^ 0x80000000u) : ~k; return __builtin_bit_cast(float, u); }

__device__ __forceinline__ void p11a_topk(const Args& a, LAS unsigned char* lds) {
    const int tid = threadIdx.x, lane = tid & 63, wave = __builtin_amdgcn_readfirstlane(tid >> 6), G = gridDim.x, bx = blockIdx.x;
    const bf16_t* PQ = (const bf16_t*)(a.ws + WS_PQ); const bf16_t* KEYS = (const bf16_t*)(a.ws + WS_KEYS);
    for (int tile = bx; tile < T_ / 32; tile += G) {
        const int t0 = tile * 32;
        __syncthreads();
        { const int r32 = lane & 31, hi = lane >> 5;
#pragma unroll 1
          for (int u = 0; u < 2; ++u) { const int hc = 2 * wave + u;
              bf16x8 qa[8];
              { const bf16_t* qp = PQ + (size_t)(t0 + r32) * 2048 + hc * 128 + 8 * hi;
#pragma unroll
                for (int ks = 0; ks < 8; ++ks) qa[ks] = *(const bf16x8*)(qp + 16 * ks); }
#pragma unroll
              for (int nb = 0; nb < 4; ++nb) { const bf16_t* kp = KEYS + (((size_t)hc * 4 + nb) * 8 * 64 + lane) * 8;
                  f32x16 acc = F16Z;
#pragma unroll
                  for (int ks = 0; ks < 8; ++ks) acc = mfma32(qa[ks], *(const bf16x8*)(kp + ks * 512), acc);
#pragma unroll
                  for (int r = 0; r < 16; r += 2) { const unsigned w = pk2(acc[r], acc[r + 1]);
                      *(LAS bf16_t*)(lds + (crow(r, hi) * 16 + hc) * PE_SP + (32 * nb + r32) * 2) = (bf16_t)(w & 0xffffu);
                      *(LAS bf16_t*)(lds + (crow(r + 1, hi) * 16 + hc) * PE_SP + (32 * nb + r32) * 2) = (bf16_t)(w >> 16); } } } }
        __syncthreads();
        unsigned tk[16];
        { const LAS unsigned char* rowp = lds + tid * PE_SP;
#pragma unroll 1
          for (int g = 0; g < 8; ++g) { const u32x4 w0 = *(const LAS u32x4*)(rowp + g * 32), w1 = *(const LAS u32x4*)(rowp + g * 32 + 16); const unsigned ww[8] = {w0.x, w0.y, w0.z, w0.w, w1.x, w1.y, w1.z, w1.w};
              unsigned grp[16];
#pragma unroll
              for (int e = 0; e < 16; ++e) grp[e] = sortkey_hi((e & 1) ? (ww[e >> 1] & 0xffff0000u) : (ww[e >> 1] << 16), g * 16 + e);
              if (g == 0) { sort16_asc(grp);
#pragma unroll
                  for (int j = 0; j < 16; ++j) tk[j] = grp[15 - j]; }
              else top16_absorb(tk, grp); } }
        __syncthreads();
#pragma unroll
        for (int j = 0; j < 16; j += 4) *(LAS u32x4*)(lds + PE_TK + tid * 64 + j * 4) = (u32x4){tk[j], tk[j + 1], tk[j + 2], tk[j + 3]};
        __syncthreads();
        if (tid < 256) {
            const int tl = tid >> 3, h = tid & 7;
            const LAS unsigned char* ta = lds + PE_TK + (tl * 16 + h * 2) * 64; const LAS unsigned char* tb_ = ta + 64;
            float av[16], bv[16];
#pragma unroll
            for (int j = 0; j < 16; ++j) { av[j] = keyval(*(const LAS unsigned*)(ta + j * 4)); bv[j] = keyval(*(const LAS unsigned*)(tb_ + j * 4)); }
            unsigned bs[16];
            {
                unsigned cand[64];
#pragma unroll
                for (int q = 0; q < 64; ++q) cand[q] = 0u;
                int n = 0;
#pragma unroll
                for (int i = 0; i < 16; ++i)
#pragma unroll
                    for (int j = 0; j < 16 / (i + 1); ++j) { cand[n] = (fsort(av[i] + bv[j]) & 0xffffff00u) | (unsigned)(255 - (16 * i + j)); ++n; }
#pragma unroll
                for (int e = 0; e < 16; ++e) bs[e] = cand[e];
#pragma unroll
                for (int g = 1; g < 4; ++g) { unsigned grp[16];
#pragma unroll
                    for (int e = 0; e < 16; ++e) grp[e] = cand[16 * g + e];
                    top16_absorb(bs, grp); }
            }
            float ev[16]; unsigned be[16]; float sum = 0.f; const float v0 = funsort(bs[0] & 0xffffff00u);
#pragma unroll
            for (int j = 0; j < 16; ++j) { const unsigned code = 255u - (bs[j] & 0xffu), ci = code >> 4, cj = code & 15u;
                const unsigned ka = *(const LAS unsigned*)(ta + ci * 4), kb = *(const LAS unsigned*)(tb_ + cj * 4);
                be[j] = (127u - (ka & 0xffffu)) * 128u + (127u - (kb & 0xffffu));
                ev[j] = ex2((funsort(bs[j] & 0xffffff00u) - v0) * LOG2E); sum += ev[j]; }
            const float isum = rcp(sum);
            float su_[16];
#pragma unroll
            for (int j = 0; j < 16; ++j) { const f32x2 sc = ((const f32x2*)(a.ws + WS_SUV))[be[j]]; su_[j] = sc.x * (1.f / PEER_XS); ev[j] *= isum * sc.y; }
#pragma unroll
            for (int j = 0; j < 16; j += 4) { const size_t o = ((size_t)(t0 + tl) * 128 + h * 16 + j); *(u32x4*)((unsigned*)(a.ws + WS_EXG) + o) = (u32x4){be[j], be[j + 1], be[j + 2], be[j + 3]};
                *(f32x4*)((float*)(a.ws + WS_GTG) + o) = (f32x4){ev[j], ev[j + 1], ev[j + 2], ev[j + 3]};
                *(f32x4*)((float*)(a.ws + WS_SUG) + o) = (f32x4){su_[j], su_[j + 1], su_[j + 2], su_[j + 3]}; }
        }
    }
}


typedef int i32x8 __attribute__((ext_vector_type(8)));
typedef int i32x2 __attribute__((ext_vector_type(2)));
__device__ __forceinline__ void p12_peer_u(const Args& a, LAS unsigned char* lds) {
    const int tid = threadIdx.x, lane = tid & 63, wave = __builtin_amdgcn_readfirstlane(tid >> 6), bx = blockIdx.x;
    const int p = bx & 3, hb = (bx >> 2) & 1, q = bx >> 3, c = lane & 15, kg = lane >> 4, r8 = lane >> 3, s8 = lane & 7;
    const bf16_t* XN = (const bf16_t*)(a.ws + WS_XN); const unsigned* EXG = (const unsigned*)(a.ws + WS_EXG);
    const unsigned char* U = a.ws + WS_UBF + (size_t)p * (2 * MiB) + 16 * (s8 ^ r8);
    bf16_t* PART = (bf16_t*)(a.ws + WS_PART) + (size_t)p * T_ * 128;
    LAS unsigned char* wl = lds + wave * 16384;
    const float* SSH = (const float*)(a.ws + WS_SSH);
    const int aoff0 = c * 128 + 16 * ((kg) ^ (c & 7)), aoff1 = c * 128 + 16 * ((kg + 4) ^ (c & 7));
    const int SC1 = 0x7f7f7f7f;
    for (int qq = q; qq < 32; qq += (int)(gridDim.x >> 3)) {
        const size_t tb = (size_t)(2 * qq + hb) * 512 + wave * 64;
        u32x4 xw[2][4]; unsigned e0, e1; float ssh; f32x4 sg;
        { const bf16_t* xp = XN + tb * 1024 + 256 * p + 16 * kg;
#pragma unroll
          for (int j = 0; j < 2; ++j)
#pragma unroll
            for (int i = 0; i < 4; ++i) xw[j][i] = *(const u32x4*)(xp + 128 * j + 64 * (i >> 1) + 8 * (i & 1));
          e0 = EXG[tb * 128 + lane]; e1 = EXG[tb * 128 + 64 + lane]; ssh = SSH[tb];
          sg = *(const f32x4*)((const float*)(a.ws + WS_SUG) + tb * 128 + 16 * (c & 7) + 4 * kg); }
        for (int ti = 0; ti < 64; ++ti) {
            const size_t t = tb + ti, t1 = ti + 1 < 64 ? t + 1 : t;
            asm volatile("s_waitcnt lgkmcnt(0)" ::: "memory");
#pragma unroll
            for (int g = 0; g < 16; ++g) {
                const unsigned e = (unsigned)__shfl((int)(g < 8 ? e0 : e1), 8 * (g & 7) + r8);
                __builtin_amdgcn_global_load_lds((const unsigned*)(U + (size_t)e * 128), (LAS unsigned*)(wl + g * 1024), 16, 0, 0);
            }
            i32x8 bfr[2];
            { const float xs = rsq(ssh * (1.f / 1024.f) + EPS_) * PEER_XS;
#pragma unroll
              for (int j = 0; j < 2; ++j)
#pragma unroll
                for (int i = 0; i < 4; ++i) { float f[8]; unpack8(xw[j][i], f);
                    int w0 = 0, w1 = 0;
                    w0 = __builtin_amdgcn_cvt_pk_fp8_f32(f[0] * xs, f[1] * xs, w0, false); w0 = __builtin_amdgcn_cvt_pk_fp8_f32(f[2] * xs, f[3] * xs, w0, true);
                    w1 = __builtin_amdgcn_cvt_pk_fp8_f32(f[4] * xs, f[5] * xs, w1, false); w1 = __builtin_amdgcn_cvt_pk_fp8_f32(f[6] * xs, f[7] * xs, w1, true);
                    bfr[j][2 * i] = w0; bfr[j][2 * i + 1] = w1; } }
            const f32x4 sgc = sg;
            { const bf16_t* xp = XN + t1 * 1024 + 256 * p + 16 * kg;
#pragma unroll
              for (int j = 0; j < 2; ++j)
#pragma unroll
                for (int i = 0; i < 4; ++i) xw[j][i] = *(const u32x4*)(xp + 128 * j + 64 * (i >> 1) + 8 * (i & 1));
              e0 = EXG[t1 * 128 + lane]; e1 = EXG[t1 * 128 + 64 + lane]; ssh = SSH[t1];
              sg = *(const f32x4*)((const float*)(a.ws + WS_SUG) + t1 * 128 + 16 * (c & 7) + 4 * kg); }
            asm volatile("s_waitcnt vmcnt(0)" ::: "memory");
            f32x4 acc[8];
#pragma unroll
            for (int rb = 0; rb < 8; ++rb) {
                const u32x4 a0 = *(const LAS u32x4*)(wl + rb * 2048 + aoff0), a1 = *(const LAS u32x4*)(wl + rb * 2048 + aoff1);
                f32x4 v = (f32x4){0.f, 0.f, 0.f, 0.f};
                v = __builtin_amdgcn_mfma_scale_f32_16x16x128_f8f6f4((i32x8){(int)a0.x, (int)a0.y, (int)a0.z, (int)a0.w, 0, 0, 0, 0}, bfr[0], v, 4, 0, 0, SC1, 0, SC1);
                v = __builtin_amdgcn_mfma_scale_f32_16x16x128_f8f6f4((i32x8){(int)a1.x, (int)a1.y, (int)a1.z, (int)a1.w, 0, 0, 0, 0}, bfr[1], v, 4, 0, 0, SC1, 0, SC1);
                acc[rb] = v;
            }
            f32x4 v = acc[0];
#pragma unroll
            for (int rb = 1; rb < 8; ++rb) { const bool sel = (c == rb); v.x = sel ? acc[rb].x : v.x; v.y = sel ? acc[rb].y : v.y; v.z = sel ? acc[rb].z : v.z; v.w = sel ? acc[rb].w : v.w; }
            if (c < 8) *(u32x2*)(PART + t * 128 + 16 * c + 4 * kg) = (u32x2){pk2(v.x * sgc.x, v.y * sgc.y), pk2(v.z * sgc.z, v.w * sgc.w)};
        }
    }
}
__device__ __forceinline__ void p13_peer_v_mfma(const Args& a, LAS unsigned char* lds) {
    const int tid = threadIdx.x, lane = tid & 63, wave = __builtin_amdgcn_readfirstlane(tid >> 6), bx = blockIdx.x;
    const int p = bx & 3, hb = (bx >> 2) & 1, q = bx >> 3, n16 = lane & 15, kg = lane >> 4, r8 = lane >> 3, s8 = lane & 7;
    const unsigned* __restrict__ EXG = (const unsigned*)(a.ws + WS_EXG); const float* __restrict__ GTG = (const float*)(a.ws + WS_GTG); const bf16_t* __restrict__ PART = (const bf16_t*)(a.ws + WS_PART);
    const unsigned char* V0 = a.ws + WS_VBF + (size_t)p * (2 * MiB) + 16 * (s8 ^ (r8 >> 1)); const unsigned char* V1 = a.ws + WS_VBF + (size_t)p * (2 * MiB) + 16 * (s8 ^ (r8 >> 1) ^ 4);
    LAS unsigned char* wl = lds + wave * 16384;
    LAS unsigned char* w8 = lds + 131072 + wave * 128;
    const int trb0 = (32 * kg + n16) * 128, trb1 = trb0 + 16 * 128, sw = n16 >> 1;
    const int SC1 = 0x7f7f7f7f;
    for (int qq = q; qq < 32; qq += (int)(gridDim.x >> 3)) {
        const size_t tb = (size_t)(2 * qq + hb) * 512 + wave * 64;
        unsigned e0 = EXG[tb * 128 + lane], e1 = EXG[tb * 128 + 64 + lane];
        unsigned e0n = EXG[(tb + 1) * 128 + lane], e1n = EXG[(tb + 1) * 128 + 64 + lane];
        bf16_t pa0[4], pa1[4]; float g0, g1;
#pragma unroll
        for (int pp = 0; pp < 4; ++pp) { pa0[pp] = PART[((size_t)pp * T_ + tb) * 128 + lane]; pa1[pp] = PART[((size_t)pp * T_ + tb) * 128 + 64 + lane]; }
        g0 = GTG[tb * 128 + lane]; g1 = GTG[tb * 128 + 64 + lane];
        for (int ti = 0; ti < 64; ++ti) {
            const size_t t = tb + ti;
            asm volatile("s_waitcnt lgkmcnt(0)" ::: "memory");
#pragma unroll
            for (int g = 0; g < 16; ++g) {
                const unsigned e = (unsigned)__shfl((int)(g < 8 ? e0 : e1), 8 * (g & 7) + r8);
                __builtin_amdgcn_global_load_lds((const unsigned*)(((g & 1) ? V1 : V0) + (size_t)e * 128), (LAS unsigned*)(wl + g * 1024), 16, 0, 0);
            }
            float a0 = 0.f, a1 = 0.f;
#pragma unroll
            for (int pp = 0; pp < 4; ++pp) { a0 += bf1(pa0[pp]); a1 += bf1(pa1[pp]); }
            const float w0 = g0 * gelu_tanh(a0), w1 = g1 * gelu_tanh(a1);
            const size_t t1 = ti + 1 < 64 ? t + 1 : t, t2 = ti + 2 < 64 ? t + 2 : t;
#pragma unroll
            for (int pp = 0; pp < 4; ++pp) { pa0[pp] = PART[((size_t)pp * T_ + t1) * 128 + lane]; pa1[pp] = PART[((size_t)pp * T_ + t1) * 128 + 64 + lane]; }
            g0 = GTG[t1 * 128 + lane]; g1 = GTG[t1 * 128 + 64 + lane];
            const unsigned e0nn = EXG[t2 * 128 + lane], e1nn = EXG[t2 * 128 + 64 + lane];
            const f32x4 hv = *(const f32x4*)(a.out + t * 1024 + 256 * p + 16 * n16 + 4 * kg);
            float wm = fmaxf(fabsf(w0), fabsf(w1));
#pragma unroll
            for (int o = 1; o < 64; o <<= 1) wm = fmaxf(wm, __shfl_xor(wm, o));
            int be = (int)(__builtin_bit_cast(unsigned, wm) >> 23); be = be < 16 ? 16 : (be > 240 ? 240 : be);
            const float sc = __builtin_bit_cast(float, (unsigned)(261 - be) << 23), isc = __builtin_bit_cast(float, (unsigned)(be - 7) << 23);
            const int pk = __builtin_amdgcn_cvt_pk_fp8_f32(w0 * sc, w1 * sc, 0, false);
            w8[lane] = (unsigned char)(pk & 0xff); w8[64 + lane] = (unsigned char)((pk >> 8) & 0xff);
            asm volatile("s_waitcnt vmcnt(0) lgkmcnt(0)" ::: "memory");
            const u32x4 aw0 = *(const LAS u32x4*)(w8 + 16 * kg), aw1 = *(const LAS u32x4*)(w8 + 64 + 16 * kg);
            const i32x8 af = (i32x8){(int)aw0.x, (int)aw0.y, (int)aw0.z, (int)aw0.w, (int)aw1.x, (int)aw1.y, (int)aw1.z, (int)aw1.w};
            f32x4 v = (f32x4){0.f, 0.f, 0.f, 0.f};
#pragma unroll
            for (int mf = 0; mf < 16; ++mf) {
                const int co = 16 * ((mf >> 1) ^ sw) + 8 * (mf & 1);
                const i32x2 b0 = __builtin_amdgcn_ds_read_tr4_b64_v2i32((LAS i32x2*)(wl + trb0 + co)), b1 = __builtin_amdgcn_ds_read_tr4_b64_v2i32((LAS i32x2*)(wl + trb1 + co));
                const f32x4 d = __builtin_amdgcn_mfma_scale_f32_16x16x128_f8f6f4((i32x8){b0.x, b0.y, b1.x, b1.y, 0, 0, 0, 0}, af, (f32x4){0.f, 0.f, 0.f, 0.f}, 4, 0, 0, SC1, 0, SC1);
                const bool sel = (n16 == mf); v.x = sel ? d.x : v.x; v.y = sel ? d.y : v.y; v.z = sel ? d.z : v.z; v.w = sel ? d.w : v.w;
            }
            *(f32x4*)(a.out + t * 1024 + 256 * p + 16 * n16 + 4 * kg) = hv + v * isc;
            e0 = e0n; e1 = e1n; e0n = e0nn; e1n = e1nn;
        }
    }
}

__global__ void __launch_bounds__(512, 2) fwd_kernel(Args a) {
    extern __shared__ __attribute__((aligned(16))) unsigned char lds_raw[];
    LAS unsigned char* lds = (LAS unsigned char*)lds_raw;
    volatile LAS unsigned* MISC = (volatile LAS unsigned*)(lds + MISC_OFF);
    const int tid = threadIdx.x, G = gridDim.x, bx = blockIdx.x;
    if (tid < 16) MISC[tid] = 0u;
    __syncthreads();
    unsigned char* ws = a.ws;
    XcdBarrier bar; bar.bar = (unsigned*)(ws + WS_CTL) + 4096; bar.x = 0; bar.st = nullptr;
    if (!MK_PER_PHASE) bar = xcd_barrier_post((unsigned*)(ws + WS_CTL) + 4096, MISC + 8);
    const int lo = a.ph_lo, hi = a.ph_hi;
#define IN(k) (lo <= (k) && (k) < hi)
#define SEAM(k) do { if (!MK_PER_PHASE && IN((k) + 1)) xcd_barrier(bar); if (DBG_TIME >= 0 && bx == 0 && tid == 0) ((unsigned long long*)(ws + WS_CTL))[100 + (k) + 1] = __builtin_amdgcn_s_memrealtime(); } while (0)
    unsigned char* dob = (unsigned char*)a.out;

    if (DBG_TIME >= 0 && bx == 0 && tid == 0) ((unsigned long long*)(ws + WS_CTL))[100] = __builtin_amdgcn_s_memrealtime();
    if (IN(0)) { p0_prologue(a, lds); SEAM(0); }
    if (IN(1)) {
        { pg8::Gemm g{1024, 1024, 1024}; pg8::SchedStd S{128, 23, G, bx, (const char*)(dob + DO_N), (const char*)(ws + WS_WIN), (size_t)256 * 1024 * 2, (size_t)256 * 1024 * 2, 0};
          pg8::EpiProj E{(bf16_t*)(ws + WS_RA), (bf16_t*)(ws + WS_RB), (bf16_t*)(ws + WS_QRET), (bf16_t*)(ws + WS_KRET), (bf16_t*)(dob + DO_GS), (bf16_t*)(dob + DO_XQ),
                         (float*)(ws + WS_SSX), a.pos, (const f32x2*)(ws + WS_CS64)};
          pg8::gemm_phase(lds, g, S, E); }
        { pg8::Gemm g{1024, 1024, 1024}; pg8::SchedStd S{8, 4, G, (bx + G - 128 % G) % G, (const char*)(ws + WS_MEMN), (const char*)(ws + WS_WMKV), (size_t)256 * 1024 * 2, (size_t)256 * 1024 * 2, 0};
          pg8::EpiBf16 E{(bf16_t*)(ws + WS_KVM), 1024};
          pg8::gemm_phase(lds, g, S, E); }
        SEAM(1);
    }
    if (IN(2)) { p2_post_proj(a, lds); SEAM(2); }
    if (IN(3)) {
        { pg8::Gemm g{512, 512, 512}; pg8::SchedStd S{128, 7, G, bx, (const char*)(dob + DO_CQKV), (const char*)(ws + WS_WUP), (size_t)256 * 512 * 2, (size_t)256 * 512 * 2, 0};
          pg8::EpiBf16 E{(bf16_t*)(ws + WS_UP), NUP};
          pg8::gemm_phase(lds, g, S, E); }
        p3_ret_incr(a);
        SEAM(3);
    }
    if (IN(4)) { p4_post_up(a, lds); SEAM(4); }
    if (IN(5)) { p5_mixers(a, lds); SEAM(5); if (DBG_CHECK) { dbg_ret_check(a); xcd_barrier(bar);
        if (bx == 0 && tid < 64) { const unsigned long long kk = __hip_atomic_load((unsigned long long*)(ws + WS_CTL) + 32, __ATOMIC_RELAXED, __HIP_MEMORY_SCOPE_AGENT); dbg_ret_eval(a, (int)(unsigned)kk); } } }
    if (IN(6)) {
        pg8::Gemm g{512, 512, 512}; pg8::SchedG4 S{G, bx, (const char*)(ws + WS_OMLA), (const char*)(dob + DO_GS), (const char*)(dob + DO_XQ), (const char*)(ws + WS_WO3)};
        pg8::EpiGate E{(bf16_t*)(ws + WS_RB), (bf16_t*)(ws + WS_MERGED)};
        pg8::gemm_phase(lds, g, S, E);
        SEAM(6);
    }
    if (IN(7)) {
        pg8::Gemm g{1024, 1024, 1024}; pg8::SchedStd S{128, 4, G, bx, (const char*)(ws + WS_MERGED), (const char*)(ws + WS_WOUT), (size_t)256 * 1024 * 2, (size_t)256 * 1024 * 2, 0};
        pg8::EpiRes E{a.out, a.x, (bf16_t*)(ws + WS_XN), (float*)(ws + WS_SSH)};
        pg8::gemm_phase(lds, g, S, E);
        table_fp4(a, a.peer_v, a.ws + WS_VBF, (float*)(a.ws + WS_SUV) + 1, nullptr);
        table_fp4(a, a.peer_u, a.ws + WS_UBF, (float*)(a.ws + WS_SUV), a.ffn_norm_g);
        SEAM(7);
    }
    if (IN(9)) {
        pg8::Gemm g{1024, 1024, 1024}; pg8::SchedStd S{128, 8, G, bx, (const char*)(ws + WS_XN), (const char*)(ws + WS_WQ), (size_t)256 * 1024 * 2, (size_t)256 * 1024 * 2, 0};
        pg8::EpiBf16S E{(bf16_t*)(ws + WS_PQ), 2048, (const float*)(ws + WS_SSH)};
        pg8::gemm_phase(lds, g, S, E);
        SEAM(9);
    }
    if (IN(11)) { p11a_topk(a, lds); SEAM(11); }
    if (IN(12)) { p12_peer_u(a, lds); SEAM(12); }
    if (IN(13)) { p13_peer_v_mfma(a, lds);
        if (DBG_TIME >= 0) { xcd_barrier(bar); if (bx == 0 && tid == 0) { const unsigned long long* st = (const unsigned long long*)(ws + WS_CTL) + 100; const unsigned long long te = __builtin_amdgcn_s_memrealtime();
            const unsigned long long d = DBG_TIME == 30 ? te - st[0] : DBG_TIME >= 20 ? ((const unsigned long long*)(ws + WS_CTL))[130] : (DBG_TIME == 13 ? te : st[DBG_TIME + 1]) - st[DBG_TIME]; a.out[0] += (float)d * 0.01f * DBG_TSCALE; } } }
#undef IN
#undef SEAM
}

extern "C" void kernel_launch(void* const* d_in, const int* in_sizes, int n_in, void* d_out, int out_size, void* d_ws, size_t ws_size, hipStream_t stream) {
    static int grid = 0;
    if (grid == 0) {
        if (n_in != 25 || out_size != T_ * D_ || ws_size < WS_END) { fprintf(stderr, "kernel_launch: unexpected shapes (n_in %d, out %d, ws %zu)\n", n_in, out_size, ws_size); grid = -1; return; }
        int dev = 0, cus = 0, per_cu = 0;
        if (hipGetDevice(&dev) != hipSuccess || hipDeviceGetAttribute(&cus, hipDeviceAttributeMultiprocessorCount, dev) != hipSuccess) { grid = -1; return; }
        if (hipFuncSetAttribute((const void*)fwd_kernel, hipFuncAttributeMaxDynamicSharedMemorySize, LDS_BYTES) != hipSuccess) { fprintf(stderr, "kernel_launch: hipFuncSetAttribute failed\n"); grid = -1; return; }
        if (hipOccupancyMaxActiveBlocksPerMultiprocessor(&per_cu, (const void*)fwd_kernel, 512, LDS_BYTES) != hipSuccess || per_cu < 1) fprintf(stderr, "kernel_launch: occupancy query reports %d\n", per_cu);
        (void)hipGetLastError();
        grid = cus;
    }
    if (grid < 0) return;
    if (hipMemsetAsync((char*)d_ws + WS_CTL, 0, CTL_ZERO_BYTES, stream) != hipSuccess) return;
    Args a{};
    a.x = (const float*)d_in[0]; a.mem = (const float*)d_in[1]; a.pos = (const int*)d_in[2];
    a.attn_norm_g = (const float*)d_in[3]; a.w_in = (const float*)d_in[4]; a.mla_q_norm_g = (const float*)d_in[5]; a.w_uq = (const float*)d_in[6];
    a.mla_kv_norm_g = (const float*)d_in[7]; a.w_ukv = (const float*)d_in[8]; a.mla_qn_g = (const float*)d_in[9]; a.mla_kn_g = (const float*)d_in[10];
    a.w_o_mla = (const float*)d_in[11]; a.ret_gn_g = (const float*)d_in[12]; a.w_o_ret = (const float*)d_in[13]; a.mem_norm_g = (const float*)d_in[14];
    a.w_mem_kv = (const float*)d_in[15]; a.x_qn_g = (const float*)d_in[16]; a.x_kn_g = (const float*)d_in[17]; a.w_o_cross = (const float*)d_in[18];
    a.w_out = (const float*)d_in[19]; a.ffn_norm_g = (const float*)d_in[20]; a.peer_w_q = (const float*)d_in[21]; a.peer_keys = (const float*)d_in[22];
    a.peer_u = (const float*)d_in[23]; a.peer_v = (const float*)d_in[24];
    a.out = (float*)d_out; a.ws = (unsigned char*)d_ws;
    for (int i = 0; i < 16; ++i) a.invf32[i] = powf(10000.0f, -(float)(2 * i) / 32.0f);
    for (int i = 0; i < 32; ++i) a.invf64[i] = powf(10000.0f, -(float)(2 * i) / 64.0f);
    for (int h = 0; h < 4; ++h) a.lg2g[h] = (float)std::log2(1.0 - std::exp2(-5.0 - (double)h));
#if MK_PER_PHASE
    for (int p = 0; p < NPHASE; ++p) { a.ph_lo = p; a.ph_hi = p + 1; hipLaunchKernelGGL(fwd_kernel, dim3(grid), dim3(512), LDS_BYTES, stream, a); }
#else
    a.ph_lo = 0; a.ph_hi = NPHASE;
    hipLaunchKernelGGL(fwd_kernel, dim3(grid), dim3(512), LDS_BYTES, stream, a);
#endif
    const hipError_t le = hipPeekAtLastError();
    if (le != hipSuccess) fprintf(stderr, "kernel_launch: launch failed: %s\n", hipGetErrorName(le));
}
```

```cpp
#include <hip/hip_runtime.h>
#include <cstdio>
#include <cstdint>
#include <cmath>

#define LAS __attribute__((address_space(3)))
#define GAS __attribute__((address_space(1)))
typedef unsigned short bf16_t;
typedef short bf16x8 __attribute__((ext_vector_type(8)));
typedef float f32x4 __attribute__((ext_vector_type(4)));
typedef float f32x2 __attribute__((ext_vector_type(2)));
typedef float f32x16 __attribute__((ext_vector_type(16)));
typedef unsigned u32x4 __attribute__((ext_vector_type(4)));
typedef unsigned u32x2 __attribute__((ext_vector_type(2)));

#ifndef DBG_ZERO
#define DBG_ZERO 0
#endif
#ifndef DBG_CHECK
#define DBG_CHECK 0
#endif
#ifndef DBG_TIME
#define DBG_TIME -1
#endif
#ifndef DBG_TSCALE
#define DBG_TSCALE 0.002f
#endif
#ifndef MK_PER_PHASE
#define MK_PER_PHASE 0
#endif

constexpr int T_ = 32768, S_ = 4096, B_ = 8, D_ = 1024, MEM_ = 256;
constexpr int NPA = 2816;
constexpr int NGT = 3072;
constexpr int NG1 = NPA + NGT;
constexpr int NUP = 1792;
constexpr float EPS_ = 1e-6f;
constexpr float LOG2E = 1.4426950408889634f;
constexpr int NPOS = 5120;
constexpr int NPHASE = 14;
constexpr float PEER_XS = 8.f;

constexpr size_t MiB = 1u << 20;
constexpr size_t WS_CTL = 0, CTL_ZERO_BYTES = 32768;
constexpr size_t WS_WIN = 1 * MiB;
constexpr size_t WS_WUP = 13 * MiB;
constexpr size_t WS_WO3 = 15 * MiB;
constexpr size_t WS_WOUT = 18 * MiB;
constexpr size_t WS_WMKV = 20 * MiB;
constexpr size_t WS_WQ = 22 * MiB;
constexpr size_t WS_KEYS = 26 * MiB;
constexpr size_t WS_CS32 = 27 * MiB;
constexpr size_t WS_CS64 = 27 * MiB + 655360;
constexpr size_t WS_MEMN = 29 * MiB;
constexpr size_t WS_KVM = 33 * MiB;
constexpr size_t WS_KX = 37 * MiB;
constexpr size_t WS_VXT = 39 * MiB;
constexpr size_t WS_SSH = 41 * MiB + 524288;
constexpr size_t WS_SSX = 41 * MiB;
constexpr size_t WS_SUV = 42 * MiB;
constexpr size_t WS_RA = 48 * MiB;
constexpr size_t WS_UP = WS_RA;
constexpr size_t WS_VMT = WS_RA + 112 * MiB;
constexpr size_t WS_OMLA = WS_RA + 144 * MiB;
constexpr size_t WS_RB = 224 * MiB;
constexpr size_t WS_RC = 416 * MiB;
constexpr size_t WS_MERGED = WS_RC;
constexpr size_t WS_QRET = WS_RC;
constexpr size_t WS_KRET = WS_RC + 16 * MiB;
constexpr size_t WS_KRETT = WS_RC + 32 * MiB;
constexpr size_t WS_INCR = WS_RC + 48 * MiB;
constexpr size_t WS_KR = WS_RC + 80 * MiB;
constexpr size_t WS_XN = WS_RA;
constexpr size_t WS_UBF = WS_RA + 64 * MiB;
constexpr size_t WS_VBF = WS_RA + 96 * MiB;
constexpr size_t WS_PQ = WS_RB;
constexpr size_t WS_SC = WS_RB + 128 * MiB;
constexpr size_t WS_EXG = 480 * MiB;
constexpr size_t WS_GTG = 496 * MiB;
constexpr size_t WS_SUG = WS_RC;
constexpr size_t WS_PART = WS_RB;
constexpr size_t WS_END = 512 * MiB;
constexpr size_t DO_N = 0, DO_CQKV = 0, DO_VRT = 32 * MiB, DO_XQ = 64 * MiB, DO_GS = 96 * MiB;

constexpr int LDS_BYTES = 147456;
constexpr int MISC_OFF = LDS_BYTES - 64;

struct Args {
    const float* x; const float* mem; const int* pos;
    const float *attn_norm_g, *w_in, *mla_q_norm_g, *w_uq, *mla_kv_norm_g, *w_ukv, *mla_qn_g, *mla_kn_g, *w_o_mla,
                *ret_gn_g, *w_o_ret, *mem_norm_g, *w_mem_kv, *x_qn_g, *x_kn_g, *w_o_cross, *w_out, *ffn_norm_g,
                *peer_w_q, *peer_keys, *peer_u, *peer_v;
    float* out; unsigned char* ws;
    float invf32[16]; float invf64[32]; float lg2g[4];
    int ph_lo, ph_hi;
};

__device__ __forceinline__ unsigned f2bf(float f) { unsigned u = __builtin_bit_cast(unsigned, f); return (u + 0x7fffu + ((u >> 16) & 1u)) >> 16; }
typedef float f32x2_t __attribute__((ext_vector_type(2))); typedef __bf16 bf16x2_t __attribute__((ext_vector_type(2)));
__device__ __forceinline__ unsigned pk2(float lo, float hi) { const f32x2_t v = {lo, hi}; const bf16x2_t b = __builtin_convertvector(v, bf16x2_t); return __builtin_bit_cast(unsigned, b); }
__device__ __forceinline__ float bflo(unsigned u) { return __builtin_bit_cast(float, u << 16); }
__device__ __forceinline__ float bfhi(unsigned u) { return __builtin_bit_cast(float, u & 0xffff0000u); }
__device__ __forceinline__ float bf1(bf16_t v) { return __builtin_bit_cast(float, ((unsigned)v) << 16); }
__device__ __forceinline__ float ex2(float x) { return __builtin_amdgcn_exp2f(x); }
__device__ __forceinline__ float rsq(float x) { return __builtin_amdgcn_rsqf(x); }
__device__ __forceinline__ float rcp(float x) { return __builtin_amdgcn_rcpf(x); }
__device__ __forceinline__ float sigmoidf_(float x) { return rcp(1.f + ex2(-x * LOG2E)); }
__device__ __forceinline__ float gelu_tanh(float x) { const float u = 0.7978845608028654f * (x + 0.044715f * x * x * x); return x * rcp(1.f + ex2(-2.f * LOG2E * u)); }
__device__ __forceinline__ float wave_sum(float v) {
#pragma unroll
    for (int o = 1; o < 64; o <<= 1) v += __shfl_xor(v, o);
    return v;
}
__device__ __forceinline__ float sum16(float v) {
#pragma unroll
    for (int o = 1; o < 16; o <<= 1) v += __shfl_xor(v, o);
    return v;
}
__device__ __forceinline__ void unpack8(const u32x4 w, float (&f)[8]) {
    f[0] = bflo(w.x); f[1] = bfhi(w.x); f[2] = bflo(w.y); f[3] = bfhi(w.y); f[4] = bflo(w.z); f[5] = bfhi(w.z); f[6] = bflo(w.w); f[7] = bfhi(w.w);
}
__device__ __forceinline__ u32x4 pack8(const float (&f)[8]) { u32x4 w; w.x = pk2(f[0], f[1]); w.y = pk2(f[2], f[3]); w.z = pk2(f[4], f[5]); w.w = pk2(f[6], f[7]); return w; }
__device__ __forceinline__ int crow(int r, int hi) { return (r & 3) + 8 * (r >> 2) + 4 * hi; }
__device__ __forceinline__ f32x16 mfma32(bf16x8 a, bf16x8 b, f32x16 c) { return __builtin_amdgcn_mfma_f32_32x32x16_bf16(a, b, c, 0, 0, 0); }
__device__ __forceinline__ float xmax32(float m) { return fmaxf(m, __shfl_xor(m, 32)); }
__device__ __forceinline__ float xsum32(float m) { return m + __shfl_xor(m, 32); }
#define F16Z ((f32x16){0.f,0.f,0.f,0.f,0.f,0.f,0.f,0.f,0.f,0.f,0.f,0.f,0.f,0.f,0.f,0.f})

#define XB_TMO      128
#define XB_XCNT(j)  (256  + 64 * (j))
#define XB_XSUB(j)  (1280 + 64 * (j))
#define XB_XGEN(j)  (2304 + 64 * (j))
#define XB_TOP      3328
#define XB_TOPGEN   3392
#define XCD_BAR_WORDS 3456
#define XB_SPIN_CAP (1u << 18)
__device__ __forceinline__ unsigned xb_ld(unsigned* p)              { return __hip_atomic_load(p, __ATOMIC_RELAXED, __HIP_MEMORY_SCOPE_AGENT); }
__device__ __forceinline__ unsigned xb_add(unsigned* p, unsigned v) { return __hip_atomic_fetch_add(p, v, __ATOMIC_RELAXED, __HIP_MEMORY_SCOPE_AGENT); }
__device__ __forceinline__ unsigned xb_xcc_id() { return (unsigned)__builtin_amdgcn_s_getreg((3 << 11) | 20) & 0xFu; }
#define XB_SPIN(cond, bar) do { unsigned _sp = 0; while (cond) { __builtin_amdgcn_s_sleep(1); \
    if ((++_sp & 255u) == 0u) { if (xb_ld(&(bar)[XB_TMO])) break; if (_sp > XB_SPIN_CAP) { atomicAdd(&(bar)[XB_TMO], 1u); break; } } } } while (0)
struct XcdBarrier { unsigned* bar; unsigned x; volatile LAS unsigned* st; };
__device__ __forceinline__ XcdBarrier xcd_barrier_post(unsigned* bar, volatile LAS unsigned* st) {
    XcdBarrier b; b.bar = bar; b.x = xb_xcc_id(); b.st = st;
    if (threadIdx.x == 0) (void)xb_add(&bar[XB_XCNT(b.x)], 1u);
    return b;
}
__device__ __forceinline__ void xcd_barrier_complete(unsigned* bar, unsigned x, unsigned& nloc, unsigned& nx) {
    const unsigned G = gridDim.x * gridDim.y * gridDim.z;
    unsigned sum, cnt, mine, sp = 0u;
    for (;;) {
        sum = 0u; cnt = 0u; mine = 0u;
#pragma unroll
        for (unsigned j = 0; j < 16; ++j) { const unsigned c = xb_ld(&bar[XB_XCNT(j)]); sum += c; cnt += (c > 0u) ? 1u : 0u; mine = (j == x) ? c : mine; }
        if (sum == G) break;
        __builtin_amdgcn_s_sleep(1);
        if ((++sp & 255u) == 0u) { if (xb_ld(&bar[XB_TMO])) break; if (sp > XB_SPIN_CAP) { atomicAdd(&bar[XB_TMO], 1u); break; } }
    }
    nloc = mine > 0u ? mine : 1u; nx = cnt > 0u ? cnt : 1u;
}
__device__ __forceinline__ void xcd_barrier(const XcdBarrier& b) {
    asm volatile("s_waitcnt vmcnt(0)" ::: "memory");
    __syncthreads();
    if (threadIdx.x == 0) {
        unsigned* bar = b.bar;
        __builtin_amdgcn_s_waitcnt(0);
        unsigned nloc = b.st[0], nx = b.st[1];
        if (nloc == 0u) { xcd_barrier_complete(bar, b.x, nloc, nx); b.st[0] = nloc; b.st[1] = nx; }
        const unsigned old = xb_add(&bar[XB_XSUB(b.x)], 1u);
        const unsigned gen = old / nloc;
        if (old + 1u == (gen + 1u) * nloc) {
            __builtin_amdgcn_fence(__ATOMIC_RELEASE, "agent");
            asm volatile("s_waitcnt vmcnt(0)" ::: "memory");
            const unsigned og = xb_add(&bar[XB_TOP], 1u);
            const unsigned tg = og / nx;
            if (og + 1u == (tg + 1u) * nx) xb_add(&bar[XB_TOPGEN], 1u);
            else XB_SPIN(xb_ld(&bar[XB_TOPGEN]) == tg, bar);
            __builtin_amdgcn_fence(__ATOMIC_ACQUIRE, "agent");
            xb_add(&bar[XB_XGEN(b.x)], 1u);
            asm volatile("s_waitcnt vmcnt(0)" ::: "memory");
        } else {
            XB_SPIN(xb_ld(&bar[XB_XGEN(b.x)]) == gen, bar);
            __builtin_amdgcn_fence(__ATOMIC_ACQUIRE, "agent");
            asm volatile("s_waitcnt vmcnt(0)" ::: "memory");
        }
    }
    __syncthreads();
}

namespace pg8 {
constexpr int BM = 256, BK = 64, HALF = 128, HTB = HALF * BK * 2, STAGE_BYTES = 8 * HTB, NXCD = 8, WGM = 8;
__host__ __device__ __forceinline__ int lds_byte(int r, int c) { const int st = (r >> 4) * 2 + (c >> 5), rr = r & 15, cc = c & 31, ob = rr * 64 + cc * 2; return st * 1024 + (ob ^ (((ob >> 9) & 1) << 5)); }
__host__ __device__ __forceinline__ void stage_rc(int b, int& R, int& C) { const int st = b / 1024, sb = b % 1024, swz = sb ^ (((sb >> 9) & 1) << 5); R = (st >> 1) * 16 + swz / 64; C = (st & 1) * 32 + (swz % 64) / 2; }
__host__ __device__ __forceinline__ int perm32(int rho) { const int n = rho >> 4, i = rho & 15; return 8 * (i >> 2) + 4 * n + (i & 3); }

struct Unit { int pm, pn; const char* a; const char* b; };
struct Gemm { int lda, ldb, K; };

__device__ __forceinline__ void tile_of(int L, int nM, int nN, int& pm, int& pn) {
    const int nwg = nM * nN; int wgid = L;
    { const int q = nwg / NXCD, r = nwg % NXCD, xcd = wgid % NXCD, off = wgid / NXCD; wgid = (xcd < r ? xcd * (q + 1) : r * (q + 1) + (xcd - r) * q) + off; }
    const int nig = WGM * nN, gid = wgid / nig, fm = gid * WGM, gsz = (nM - fm) < WGM ? (nM - fm) : WGM;
    pm = fm + ((wgid % nig) % gsz); pn = (wgid % nig) / gsz;
}
struct SchedStd {
    int nM, nN, G, c; const char* A; const char* B; size_t a_tile, b_tile, a_pn;
    __device__ __forceinline__ bool next(int i, Unit& u) const {
        const long L = (long)i * G + c; if (L >= (long)nM * nN) return false;
        int pm, pn; tile_of((int)L, nM, nN, pm, pn); u.pm = pm; u.pn = pn;
        u.a = A + (size_t)pm * a_tile + (size_t)pn * a_pn; u.b = B + (size_t)pn * b_tile; return true;
    }
};
struct SchedG4 {
    int G, c; const char* A0; const char* A1; const char* A2; const char* B;
    __device__ __forceinline__ bool next(int i, Unit& u) const {
        const int tile = i / 3, b = i - 3 * tile; const long L = (long)tile * G + c; if (L >= 512) return false;
        int pm, pn; tile_of((int)L, 128, 4, pm, pn); u.pm = pm; u.pn = 4 * b + pn;
        const unsigned long long m0 = b == 0 ? ~0ull : 0ull, m1 = b == 1 ? ~0ull : 0ull, m2 = b == 2 ? ~0ull : 0ull;
        const char* A = (const char*)(((unsigned long long)A0 & m0) | ((unsigned long long)A1 & m1) | ((unsigned long long)A2 & m2));
        u.a = A + (size_t)pm * (256 * 512 * 2); u.b = B + (size_t)(4 * b + pn) * (256 * 512 * 2); return true;
    }
};

struct EpiBf16 {
    static constexpr bool PERM = true;
    bf16_t* O; int ldc;
    __device__ __forceinline__ void operator()(const f32x4 (&acc)[2][2][4][2], const Unit& u, int wr, int wc, int fr, int fq) const {
        const int row0 = u.pm * BM + wr * 64 + fr, col0 = u.pn * BM + wc * 32 + 8 * fq;
#pragma unroll
        for (int ai = 0; ai < 2; ++ai)
#pragma unroll
            for (int m = 0; m < 4; ++m) { bf16_t* rowp = O + (size_t)(row0 + ai * HALF + m * 16) * ldc + col0;
#pragma unroll
                for (int bj = 0; bj < 2; ++bj) { const f32x4 v0 = acc[ai][bj][m][0], v1 = acc[ai][bj][m][1];
                    u32x4 w; w.x = pk2(v0[0], v0[1]); w.y = pk2(v0[2], v0[3]); w.z = pk2(v1[0], v1[1]); w.w = pk2(v1[2], v1[3]);
                    *(u32x4*)(rowp + bj * HALF) = w; } }
    }
};
struct EpiProj {
    static constexpr bool PERM = true;
    bf16_t* PA; bf16_t* GT; bf16_t* QR; bf16_t* KR; bf16_t* GS; bf16_t* XQ; float* SSX; const int* POS; const f32x2* CS64;
    __device__ __forceinline__ void operator()(const f32x4 (&acc)[2][2][4][2], const Unit& u, int wr, int wc, int fr, int fq) const {
        const int pn = u.pn;
        const int row0 = u.pm * BM + wr * 64 + fr, cin = wc * 32 + 8 * fq;
        if (pn == 2 || pn == 3) {
            const unsigned long long mq = pn == 2 ? ~0ull : 0ull;
            bf16_t* dst = (bf16_t*)(((unsigned long long)QR & mq) | ((unsigned long long)KR & ~mq)); const float sc = pn == 2 ? 1.f : 0.125f; const int jg = 4 * (wc & 1) + fq;
#pragma unroll
            for (int ai = 0; ai < 2; ++ai)
#pragma unroll
                for (int m = 0; m < 4; ++m) { const int row = row0 + ai * HALF + m * 16; const int p = POS[row]; const int pc = p < 0 ? 0 : (p >= NPOS ? NPOS - 1 : p);
                    const f32x4 t0 = *(const f32x4*)(CS64 + (size_t)pc * 32 + 4 * jg), t1 = *(const f32x4*)(CS64 + (size_t)pc * 32 + 4 * jg + 2);
#pragma unroll
                    for (int bj = 0; bj < 2; ++bj) { const f32x4 v0 = acc[ai][bj][m][0], v1 = acc[ai][bj][m][1]; const int head = 2 * bj + (wc >> 1);
                        u32x4 w;
                        w.x = pk2((v0[0] * t0.x - v1[0] * t0.y) * sc, (v0[1] * t0.z - v1[1] * t0.w) * sc); w.y = pk2((v0[2] * t1.x - v1[2] * t1.y) * sc, (v0[3] * t1.z - v1[3] * t1.w) * sc);
                        w.z = pk2((v0[0] * t0.y + v1[0] * t0.x) * sc, (v0[1] * t0.w + v1[1] * t0.z) * sc); w.w = pk2((v0[2] * t1.y + v1[2] * t1.x) * sc, (v0[3] * t1.w + v1[3] * t1.z) * sc);
                        *(u32x4*)(dst + (size_t)row * 256 + head * 64 + 8 * jg) = w; } }
            return;
        }
        if (pn == 8 || pn == 9) {
#pragma unroll
            for (int ai = 0; ai < 2; ++ai)
#pragma unroll
                for (int m = 0; m < 4; ++m) { const int row = row0 + ai * HALF + m * 16;
#pragma unroll
                    for (int bj = 0; bj < 2; ++bj) { const f32x4 v0 = acc[ai][bj][m][0], v1 = acc[ai][bj][m][1]; const int head = 2 * (pn - 8) + bj;
                        float ss = (v0[0] * v0[0] + v0[1] * v0[1]) + (v0[2] * v0[2] + v0[3] * v0[3]) + (v1[0] * v1[0] + v1[1] * v1[1]) + (v1[2] * v1[2] + v1[3] * v1[3]);
                        ss += __shfl_xor(ss, 16); ss += __shfl_xor(ss, 32);
                        if (fq == 0) atomicAdd(SSX + (size_t)row * 4 + head, ss);
                        u32x4 w; w.x = pk2(v0[0], v0[1]); w.y = pk2(v0[2], v0[3]); w.z = pk2(v1[0], v1[1]); w.w = pk2(v1[2], v1[3]);
                        *(u32x4*)(XQ + (size_t)row * 512 + head * 128 + cin) = w; } }
            return;
        }
        if (pn >= 11) {
            const int tid_ = ((wr * 4 + wc) * 4 + fq) * 16 + fr;
            bf16_t* gb = GT + ((((size_t)u.pm * 12 + (pn - 11)) * 16) * 512 + tid_) * 8;
#pragma unroll
            for (int ai = 0; ai < 2; ++ai)
#pragma unroll
                for (int m = 0; m < 4; ++m)
#pragma unroll
                    for (int bj = 0; bj < 2; ++bj) { f32x4 v0 = acc[ai][bj][m][0], v1 = acc[ai][bj][m][1];
#pragma unroll
                        for (int e = 0; e < 4; ++e) { v0[e] = rcp(1.f + ex2(v0[e])); v1[e] = rcp(1.f + ex2(v1[e])); }
                        u32x4 w; w.x = pk2(v0[0], v0[1]); w.y = pk2(v0[2], v0[3]); w.z = pk2(v1[0], v1[1]); w.w = pk2(v1[2], v1[3]);
                        *(u32x4*)(gb + (size_t)(ai * 8 + m * 2 + bj) * 4096) = w; }
            return;
        }
        if (pn == 10 && wc != 0) return;
        const bool isg = false, issl = (pn == 6 || pn == 7);
        const unsigned long long mg = 0ull, ms = issl ? ~0ull : 0ull;
        bf16_t* base = (bf16_t*)(((unsigned long long)GT & mg) | ((unsigned long long)GS & ms) | ((unsigned long long)PA & ~(mg | ms))); const int ldc = issl ? 512 : NPA;
        const int col0 = (issl ? pn - 6 : pn) * BM + cin;
#pragma unroll
        for (int ai = 0; ai < 2; ++ai)
#pragma unroll
            for (int m = 0; m < 4; ++m) { bf16_t* rowp = base + (size_t)(row0 + ai * HALF + m * 16) * ldc + col0;
#pragma unroll
                for (int bj = 0; bj < 2; ++bj) { f32x4 v0 = acc[ai][bj][m][0], v1 = acc[ai][bj][m][1];
                    if (pn == 10 && bj != 0) continue;
                    if (isg) {
#pragma unroll
                        for (int e = 0; e < 4; ++e) { v0[e] = sigmoidf_(v0[e]); v1[e] = sigmoidf_(v1[e]); } }
                    if (issl) {
#pragma unroll
                        for (int e = 0; e < 4; ++e) { v0[e] = v0[e] * sigmoidf_(v0[e]); v1[e] = v1[e] * sigmoidf_(v1[e]); } }
                    u32x4 w; w.x = pk2(v0[0], v0[1]); w.y = pk2(v0[2], v0[3]); w.z = pk2(v1[0], v1[1]); w.w = pk2(v1[2], v1[3]);
                    *(u32x4*)(rowp + bj * HALF) = w; } }
    }
};
struct EpiGate {
    static constexpr bool PERM = true;
    bf16_t* GT; bf16_t* MG;
    __device__ __forceinline__ void operator()(const f32x4 (&acc)[2][2][4][2], const Unit& u, int wr, int wc, int fr, int fq) const {
        const int b = u.pn >> 2, pn = u.pn & 3;
        const int row0 = u.pm * BM + wr * 64 + fr, col0 = pn * BM + wc * 32 + 8 * fq;
        const int tid_ = ((wr * 4 + wc) * 4 + fq) * 16 + fr;
        const bf16_t* gb = GT + ((((size_t)u.pm * 12 + u.pn) * 16) * 512 + tid_) * 8;
        bf16_t* pb = GT + ((((size_t)u.pm * 12 + pn) * 16) * 512 + tid_) * 8;
#pragma unroll
        for (int ai = 0; ai < 2; ++ai) {
            u32x4 gw[4][2], pw[4][2];
#pragma unroll
            for (int m = 0; m < 4; ++m)
#pragma unroll
                for (int bj = 0; bj < 2; ++bj) { const size_t ko = (size_t)(ai * 8 + m * 2 + bj) * 4096;
                    gw[m][bj] = *(const u32x4*)(gb + ko); pw[m][bj] = (b > 0) ? *(const u32x4*)(pb + ko) : (u32x4){0u, 0u, 0u, 0u}; }
#pragma unroll
            for (int m = 0; m < 4; ++m)
#pragma unroll
                for (int bj = 0; bj < 2; ++bj) {
                    const f32x4 v0 = acc[ai][bj][m][0], v1 = acc[ai][bj][m][1];
                    float g[8], p[8], r[8]; unpack8(gw[m][bj], g); unpack8(pw[m][bj], p);
                    r[0] = g[0] * v0[0] + p[0]; r[1] = g[1] * v0[1] + p[1]; r[2] = g[2] * v0[2] + p[2]; r[3] = g[3] * v0[3] + p[3];
                    r[4] = g[4] * v1[0] + p[4]; r[5] = g[5] * v1[1] + p[5]; r[6] = g[6] * v1[2] + p[6]; r[7] = g[7] * v1[3] + p[7];
                    if (b < 2) *(u32x4*)(pb + (size_t)(ai * 8 + m * 2 + bj) * 4096) = pack8(r);
                    else *(u32x4*)(MG + (size_t)(row0 + ai * HALF + m * 16) * 1024 + col0 + bj * HALF) = pack8(r); }
        }
    }
};
struct EpiRes {
    static constexpr bool PERM = true;
    float* C; const float* X; bf16_t* HB; float* SS;
    __device__ __forceinline__ void operator()(const f32x4 (&acc)[2][2][4][2], const Unit& u, int wr, int wc, int fr, int fq) const {
        const int row0 = u.pm * BM + wr * 64 + fr, col0 = u.pn * BM + wc * 32 + 8 * fq;
#pragma unroll
        for (int ai = 0; ai < 2; ++ai) {
            f32x4 xv[4][2][2];
#pragma unroll
            for (int m = 0; m < 4; ++m)
#pragma unroll
                for (int bj = 0; bj < 2; ++bj)
#pragma unroll
                    for (int n = 0; n < 2; ++n) xv[m][bj][n] = *(const f32x4*)(X + (size_t)(row0 + ai * HALF + m * 16) * 1024 + col0 + bj * HALF + n * 4);
#pragma unroll
            for (int m = 0; m < 4; ++m) { const size_t ro = (size_t)(row0 + ai * HALF + m * 16) * 1024 + col0; float ss = 0.f;
#pragma unroll
                for (int bj = 0; bj < 2; ++bj) { const f32x4 h0 = acc[ai][bj][m][0] + xv[m][bj][0], h1 = acc[ai][bj][m][1] + xv[m][bj][1];
                    *(f32x4*)(C + ro + bj * HALF) = h0; *(f32x4*)(C + ro + bj * HALF + 4) = h1;
                    *(u32x4*)(HB + ro + bj * HALF) = (u32x4){pk2(h0.x, h0.y), pk2(h0.z, h0.w), pk2(h1.x, h1.y), pk2(h1.z, h1.w)};
                    ss += ((h0.x * h0.x + h0.y * h0.y) + (h0.z * h0.z + h0.w * h0.w)) + ((h1.x * h1.x + h1.y * h1.y) + (h1.z * h1.z + h1.w * h1.w)); }
                ss += __shfl_xor(ss, 16); ss += __shfl_xor(ss, 32);
                if (fq == 0) atomicAdd(SS + row0 + ai * HALF + m * 16, ss); }
        }
    }
};
struct EpiBf16S {
    static constexpr bool PERM = true;
    bf16_t* O; int ldc; const float* SS;
    __device__ __forceinline__ void operator()(const f32x4 (&acc)[2][2][4][2], const Unit& u, int wr, int wc, int fr, int fq) const {
        const int row0 = u.pm * BM + wr * 64 + fr, col0 = u.pn * BM + wc * 32 + 8 * fq;
#pragma unroll
        for (int ai = 0; ai < 2; ++ai)
#pragma unroll
            for (int m = 0; m < 4; ++m) { const int row = row0 + ai * HALF + m * 16; const float rs = rsq(SS[row] * (1.f / 1024.f) + EPS_); bf16_t* rowp = O + (size_t)row * ldc + col0;
#pragma unroll
                for (int bj = 0; bj < 2; ++bj) { const f32x4 v0 = acc[ai][bj][m][0] * rs, v1 = acc[ai][bj][m][1] * rs;
                    u32x4 w; w.x = pk2(v0[0], v0[1]); w.y = pk2(v0[2], v0[3]); w.z = pk2(v1[0], v1[1]); w.w = pk2(v1[2], v1[3]);
                    *(u32x4*)(rowp + bj * HALF) = w; } }
    }
};

template <class Epi, class Sched>
__device__ __forceinline__ void gemm_phase(LAS unsigned char* lds, const Gemm g, const Sched& S, const Epi& E) {
    const int tid = threadIdx.x, wid = __builtin_amdgcn_readfirstlane(tid >> 6), lane = tid & 63, wr = wid >> 2, wc = wid & 3, fr = lane & 15, fq = lane >> 4;
    const int K = g.K, nt = K / BK;
    unsigned voffA[2], voffB[2];
#pragma unroll
    for (int i = 0; i < 2; ++i) { int R, C; stage_rc(tid * 16 + i * 8192, R, C); const int Rb = Epi::PERM ? ((R & ~31) + perm32(R & 31)) : R;
        voffA[i] = (unsigned)(R * g.lda + C) * 2u; voffB[i] = (unsigned)(Rb * g.ldb + C) * 2u; }
    const size_t kstep = (size_t)(BK * 2);
    const size_t hstepA = (size_t)HALF * g.lda * 2, hstepB = (size_t)HALF * g.ldb * 2;
    const unsigned ldsw = (unsigned)wid * 1024u;
    const int aoff = lds_byte(wr * 64 + fr, fq * 8), boff = lds_byte(wc * 32 + fr, fq * 8);
#define PG8_SA(b, h) (((b) * 2 + (h)) * HTB)
#define PG8_SB(b, h) ((4 + (b) * 2 + (h)) * HTB)
#define PG8_STAGE(bufoff, gbase, voff) do { _Pragma("unroll") for (int _i = 0; _i < 2; ++_i) \
        __builtin_amdgcn_global_load_lds((const unsigned*)((const char*)(gbase) + (voff)[_i]), (LAS unsigned*)(lds + (bufoff) + ldsw + _i * 8192), 16, 0, 0); } while (0)
#define PG8_LDA(dst, b, h) do { _Pragma("unroll") for (int m = 0; m < 4; ++m) _Pragma("unroll") for (int k = 0; k < 2; ++k) dst[m][k] = *(const LAS bf16x8*)(lds + PG8_SA(b, h) + aoff + m * 2048 + k * 1024); } while (0)
#define PG8_LDB(dst, b, h) do { _Pragma("unroll") for (int n = 0; n < 2; ++n) _Pragma("unroll") for (int k = 0; k < 2; ++k) dst[n][k] = *(const LAS bf16x8*)(lds + PG8_SB(b, h) + boff + n * 2048 + k * 1024); } while (0)
#define PG8_MMA(ai, bj, At, Bt) do { __builtin_amdgcn_s_setprio(1); _Pragma("unroll") for (int m = 0; m < 4; ++m) _Pragma("unroll") for (int n = 0; n < 2; ++n) _Pragma("unroll") for (int k = 0; k < 2; ++k) \
        acc[ai][bj][m][n] = __builtin_amdgcn_mfma_f32_16x16x32_bf16(Bt[n][k], At[m][k], acc[ai][bj][m][n], 0, 0, 0); __builtin_amdgcn_s_setprio(0); } while (0)
#define PG8_WAIT_V(n) asm volatile("s_waitcnt vmcnt(" #n ")" ::: "memory")
#define PG8_WAIT_L(n) asm volatile("s_waitcnt lgkmcnt(" #n ")" ::: "memory")
#define PG8_BAR __builtin_amdgcn_s_barrier()
#define PG8_SCHED __builtin_amdgcn_sched_barrier(0)
    Unit cur, nxt; int ui = 0;
    if (!S.next(0, cur)) return;
    f32x4 acc[2][2][4][2];
#pragma unroll
    for (int a = 0; a < 2; ++a)
#pragma unroll
        for (int b = 0; b < 2; ++b)
#pragma unroll
            for (int m = 0; m < 4; ++m)
#pragma unroll
                for (int n = 0; n < 2; ++n) acc[a][b][m][n] = (f32x4){0.f, 0.f, 0.f, 0.f};
    bf16x8 At[4][2], B0[2][2], B1[2][2];
    const char* cA = cur.a; const char* cB = cur.b;
    PG8_STAGE(PG8_SB(0, 0), cB, voffB); PG8_STAGE(PG8_SA(0, 0), cA, voffA); PG8_STAGE(PG8_SB(0, 1), cB + hstepB, voffB); PG8_STAGE(PG8_SA(0, 1), cA + hstepA, voffA);
    if (wr == 1) PG8_BAR;
    PG8_WAIT_V(4); PG8_BAR;
    PG8_STAGE(PG8_SB(1, 0), cB + kstep, voffB); PG8_STAGE(PG8_SA(1, 0), cA + kstep, voffA); PG8_STAGE(PG8_SB(1, 1), cB + hstepB + kstep, voffB);
    PG8_WAIT_V(6); PG8_BAR;
    for (;;) {
        const bool has_next = S.next(ui + 1, nxt);
        const char* nA = has_next ? nxt.a : cA; const char* nB = has_next ? nxt.b : cB;
        for (int t = 0; t < nt; t += 2) {
            const bool last = (t == nt - 2);
            const char* a1 = cA + (size_t)(t + 1) * kstep;
            const char* a2 = last ? nA : cA + (size_t)(t + 2) * kstep; const char* b2 = last ? nB : cB + (size_t)(t + 2) * kstep;
            const char* a3 = a2 + kstep; const char* b3 = b2 + kstep;
            PG8_LDB(B0, 0, 0); PG8_SCHED; PG8_LDA(At, 0, 0); PG8_STAGE(PG8_SA(1, 1), a1 + hstepA, voffA);
            PG8_WAIT_L(8); PG8_BAR; PG8_WAIT_L(0); PG8_MMA(0, 0, At, B0); PG8_BAR; PG8_SCHED;
            PG8_LDB(B1, 0, 1); PG8_STAGE(PG8_SB(0, 0), b2, voffB);
            PG8_BAR; PG8_WAIT_L(0); PG8_MMA(0, 1, At, B1); PG8_BAR;
            PG8_LDA(At, 0, 1); PG8_STAGE(PG8_SA(0, 0), a2, voffA);
            PG8_BAR; PG8_WAIT_L(0); PG8_MMA(1, 0, At, B0); PG8_BAR; PG8_SCHED;
            PG8_STAGE(PG8_SB(0, 1), b2 + hstepB, voffB);
            PG8_WAIT_V(6); PG8_BAR; PG8_MMA(1, 1, At, B1); PG8_BAR;
            PG8_LDB(B0, 1, 0); PG8_SCHED; PG8_LDA(At, 1, 0); PG8_STAGE(PG8_SA(0, 1), a2 + hstepA, voffA);
            PG8_WAIT_L(8); PG8_BAR; PG8_WAIT_L(0); PG8_MMA(0, 0, At, B0); PG8_BAR; PG8_SCHED;
            PG8_LDB(B1, 1, 1); PG8_STAGE(PG8_SB(1, 0), b3, voffB);
            PG8_BAR; PG8_WAIT_L(0); PG8_MMA(0, 1, At, B1); PG8_BAR;
            PG8_LDA(At, 1, 1); PG8_STAGE(PG8_SA(1, 0), a3, voffA);
            PG8_BAR; PG8_WAIT_L(0); PG8_MMA(1, 0, At, B0); PG8_BAR; PG8_SCHED;
            PG8_STAGE(PG8_SB(1, 1), b3 + hstepB, voffB);
            PG8_WAIT_V(6); PG8_BAR; PG8_MMA(1, 1, At, B1); PG8_BAR;
        }
        E(acc, cur, wr, wc, fr, fq);
        if (!has_next) break;
#pragma unroll
        for (int a = 0; a < 2; ++a)
#pragma unroll
            for (int b = 0; b < 2; ++b)
#pragma unroll
                for (int m = 0; m < 4; ++m)
#pragma unroll
                    for (int n = 0; n < 2; ++n) acc[a][b][m][n] = (f32x4){0.f, 0.f, 0.f, 0.f};
        cur = nxt; cA = nA; cB = nB; ++ui;
    }
    PG8_WAIT_V(0);
    if (wr == 0) PG8_BAR;
    PG8_BAR;
#undef PG8_SA
#undef PG8_SB
#undef PG8_STAGE
#undef PG8_LDA
#undef PG8_LDB
#undef PG8_MMA
#undef PG8_WAIT_V
#undef PG8_WAIT_L
#undef PG8_BAR
#undef PG8_SCHED
}
}

template <class F>
__device__ __forceinline__ void tr_tile(F f, bf16_t* dst, int ldd, int j0, int k0, LAS float* scr) {
    const int tid = threadIdx.x, tx = tid & 63, ty = tid >> 6;
#pragma unroll
    for (int i = 0; i < 8; ++i) { const int kk = ty + 8 * i; scr[kk * 65 + tx] = f(k0 + kk, j0 + tx); }
    __syncthreads();
    { const int jj = tid >> 3, c = tid & 7; const LAS float* s = scr + (8 * c) * 65 + jj;
      u32x4 o; o.x = pk2(s[0], s[65]); o.y = pk2(s[2 * 65], s[3 * 65]); o.z = pk2(s[4 * 65], s[5 * 65]); o.w = pk2(s[6 * 65], s[7 * 65]);
      *(u32x4*)(dst + (size_t)(j0 + jj) * ldd + k0 + 8 * c) = o; }
    __syncthreads();
}
__device__ __forceinline__ int win_src_col(int j) {
    if (j < 512) return j;
    if (j >= 512 && j < 1024) { const int loc = j - 512, hh = loc >> 6, sl = loc & 63, jg = sl >> 3, e = sl & 7; return 544 + hh * 64 + ((e < 4) ? 4 * jg + e : 32 + 4 * jg + (e - 4)); }
    if (j < 2560) return j + 32;
    if (j < 2592) return j - 2048;
    if (j < 2816) return -1;
    return j - 224;
}
__device__ __forceinline__ void sincos_d(float ang, float& c, float& s) {
    const double TWO_PI = 6.283185307179586476925;
    double x = (double)ang; const double n = __builtin_rint(x * (1.0 / TWO_PI)); x -= n * TWO_PI;
    const double x2 = x * x;
    const double SC[16] = {1.0, -0.16666666666666666, 0.008333333333333333, -0.0001984126984126984, 2.7557319223985893e-06, -2.505210838544172e-08, 1.6059043836821613e-10, -7.647163731819816e-13,
                           2.8114572543455206e-15, -8.22063524662433e-18, 1.9572941063391263e-20, -3.868170170630684e-23, 6.446950284384474e-26, -9.183689863795546e-29, 1.1309962886447716e-31, -1.216125041553518e-34};
    const double CC[16] = {1.0, -0.5, 0.041666666666666664, -0.001388888888888889, 2.48015873015873e-05, -2.755731922398589e-07, 2.08767569878681e-09, -1.1470745597729725e-11,
                           4.779477332387385e-14, -1.5619206968586225e-16, 4.110317623312165e-19, -8.896791392450574e-22, 1.6117375710961184e-24, -2.4795962632247976e-27, 3.279889237069838e-30, -3.7699876288159054e-33};
    double ps = SC[15], pc = CC[15];
#pragma unroll
    for (int k = 14; k >= 0; --k) { ps = __builtin_fma(ps, x2, SC[k]); pc = __builtin_fma(pc, x2, CC[k]); }
    c = (float)pc; s = (float)(ps * x);
}
template <int NR>
__device__ __forceinline__ void rms_rows_to_bf16(const float* __restrict__ xrow, const float* __restrict__ g, bf16_t* __restrict__ orow, int lane) {
    f32x4 v[NR][4];
#pragma unroll
    for (int r = 0; r < NR; ++r)
#pragma unroll
        for (int j = 0; j < 4; ++j) v[r][j] = ((const f32x4*)(xrow + (size_t)r * 1024) + lane)[64 * j];
    const f32x4* gr = (const f32x4*)g + lane;
    f32x4 gg[4];
#pragma unroll
    for (int j = 0; j < 4; ++j) gg[j] = gr[64 * j];
#pragma unroll
    for (int r = 0; r < NR; ++r) {
        float s = 0.f;
#pragma unroll
        for (int j = 0; j < 4; ++j) s += (v[r][j].x * v[r][j].x + v[r][j].y * v[r][j].y) + (v[r][j].z * v[r][j].z + v[r][j].w * v[r][j].w);
        const float rinv = rsq(wave_sum(s) * (1.f / 1024.f) + EPS_);
        u32x2* o8 = (u32x2*)(orow + (size_t)r * 1024) + lane;
#pragma unroll
        for (int j = 0; j < 4; ++j) { u32x2 w; w.x = pk2(v[r][j].x * rinv * gg[j].x, v[r][j].y * rinv * gg[j].y); w.y = pk2(v[r][j].z * rinv * gg[j].z, v[r][j].w * rinv * gg[j].w); o8[64 * j] = w; }
    }
}

__device__ __forceinline__ void p0_prologue(const Args& a, LAS unsigned char* lds) {
    const int tid = threadIdx.x, lane = tid & 63, wave = tid >> 6, G = gridDim.x, bx = blockIdx.x;
    LAS float* scr = (LAS float*)lds;
    unsigned char* ws = a.ws;
    constexpr int I_WIN = (NG1 / 64) * 16, I_WUP = (NUP / 64) * 8, I_WO3 = 48 * 8, I_WOUT = 16 * 16, I_WMKV = 16 * 16, I_WQ = 32 * 16;
    constexpr int NIT = I_WIN + I_WUP + I_WO3 + I_WOUT + I_WMKV + I_WQ;
    const int gt = bx * 512 + tid, NT = G * 512;
    for (int i = gt; i < 8 * 2 * 128 * 16; i += NT) {
        const float* src = a.peer_keys + (size_t)i * 8;
        const f32x4 p = *(const f32x4*)src, q = *(const f32x4*)(src + 4);
        const int dg = i & 15, n = (i >> 4) & 127, hc = i >> 11; const size_t di = ((((size_t)hc * 4 + (n >> 5)) * 8 + (dg >> 1)) * 64 + (dg & 1) * 32 + (n & 31));
        *(u32x4*)((bf16_t*)(ws + WS_KEYS) + di * 8) = (u32x4){pk2(p.x, p.y), pk2(p.z, p.w), pk2(q.x, q.y), pk2(q.z, q.w)};
    }
    for (int i = gt; i < T_; i += NT) *(f32x4*)((float*)(ws + WS_SSX) + (size_t)i * 4) = (f32x4){0.f, 0.f, 0.f, 0.f};
    for (int i = gt; i < T_; i += NT) ((float*)(ws + WS_SSH))[i] = 0.f;
    for (int i = gt; i < NPOS * 48; i += NT) {
        const int p = i / 48, f = i % 48; float c, s;
        if (f < 16) { sincos_d((float)p * a.invf32[f], c, s); ((f32x2*)(ws + WS_CS32))[p * 16 + f] = (f32x2){c, s}; }
        else { sincos_d((float)p * a.invf64[f - 16], c, s); ((f32x2*)(ws + WS_CS64))[p * 32 + (f - 16)] = (f32x2){c, s}; }
    }
    const int gw = bx * 8 + wave, NGW = G * 8;
    bf16_t* nb = (bf16_t*)((unsigned char*)a.out + DO_N);
    const bool flip0 = ((bx >> 3) & 1) != 0;
#pragma unroll 1
    for (int st = 0; st < 2; ++st) {
        if ((flip0 ? 1 - st : st) == 0) {
    for (int it = bx; it < NIT; it += G) {
        int r = it;
        if (r < I_WIN) { const int jt = r / 16, kt = r % 16; const float* W = a.w_in;
            tr_tile([=](int k, int j) { const int c = win_src_col(j); return c >= 0 ? W[(size_t)k * 5664 + c] * (j >= 2816 ? -LOG2E : 1.f) : 0.f; }, (bf16_t*)(ws + WS_WIN), 1024, jt * 64, kt * 64, scr); continue; } r -= I_WIN;
        if (r < I_WUP) { const int jt = r / 8, kt = r % 8; const float* Wq = a.w_uq; const float* Wk = a.w_ukv;
            tr_tile([=](int k, int j) { return j < 768 ? (k < 384 ? Wq[(size_t)k * 768 + j] : 0.f) : (k >= 384 ? Wk[(size_t)(k - 384) * 1024 + (j - 768)] : 0.f); }, (bf16_t*)(ws + WS_WUP), 512, jt * 64, kt * 64, scr); continue; } r -= I_WUP;
        if (r < I_WO3) { const int jt = r / 8, kt = r % 8; const int b = jt / 16; const float* W = b == 0 ? a.w_o_mla : (b == 1 ? a.w_o_ret : a.w_o_cross);
            tr_tile([=](int k, int j) { return W[(size_t)k * 1024 + (j & 1023)]; }, (bf16_t*)(ws + WS_WO3), 512, jt * 64, kt * 64, scr); continue; } r -= I_WO3;
        if (r < I_WOUT) { const int jt = r / 16, kt = r % 16; const float* W = a.w_out;
            tr_tile([=](int k, int j) { return W[(size_t)k * 1024 + j]; }, (bf16_t*)(ws + WS_WOUT), 1024, jt * 64, kt * 64, scr); continue; } r -= I_WOUT;
        if (r < I_WMKV) { const int jt = r / 16, kt = r % 16; const float* W = a.w_mem_kv;
            tr_tile([=](int k, int j) { return W[(size_t)k * 1024 + j]; }, (bf16_t*)(ws + WS_WMKV), 1024, jt * 64, kt * 64, scr); continue; } r -= I_WMKV;
        { const int jt = r / 16, kt = r % 16; const float* W = a.peer_w_q;
            const float* gn = a.ffn_norm_g; tr_tile([=](int k, int j) { return W[(size_t)k * 2048 + j] * gn[k]; }, (bf16_t*)(ws + WS_WQ), 1024, jt * 64, kt * 64, scr); }
    }
        } else {
    for (int m = gw * 4; m < T_; m += NGW * 4) rms_rows_to_bf16<4>(a.x + (size_t)m * 1024, a.attn_norm_g, nb + (size_t)m * 1024, lane);
    for (int m = gw; m < B_ * MEM_; m += NGW) rms_rows_to_bf16<1>(a.mem + (size_t)m * 1024, a.mem_norm_g, (bf16_t*)(ws + WS_MEMN) + (size_t)m * 1024, lane);
        }
    }
}

__device__ __forceinline__ int tr_slot(int tl, int ch) { return ch ^ ((tl >> 3) & 7); }
__device__ __forceinline__ void tr_store_cols(const LAS unsigned char* tile, int pitchB, int ncol, bf16_t* dst, size_t ldd, int s0, int ngrp = 8) {
    const int c = threadIdx.x & 7; if (c >= ngrp) return;
    for (int col = threadIdx.x >> 3; col < ncol; col += 64) {
        const LAS unsigned char* p = tile + (8 * c) * pitchB + ((col >> 3) ^ c) * 16 + (col & 7) * 2;
        unsigned w[4];
#pragma unroll
        for (int e = 0; e < 4; ++e) { const unsigned lo = *(const LAS bf16_t*)(p + (2 * e) * pitchB), hi = *(const LAS bf16_t*)(p + (2 * e + 1) * pitchB); w[e] = lo | (hi << 16); }
        *(u32x4*)(dst + (size_t)col * ldd + s0 + 8 * c) = (u32x4){w[0], w[1], w[2], w[3]};
    }
}
constexpr int P2_VT_PITCH = 1040, P2_KT_PITCH = 528, P2_KT_OFF = 64 * P2_VT_PITCH;

__device__ __forceinline__ void p2_post_proj(const Args& a, LAS unsigned char* lds) {
    const int tid = threadIdx.x, lane = tid & 63, wave = tid >> 6, G = gridDim.x, bx = blockIdx.x;
    unsigned char* ws = a.ws; unsigned char* dob = (unsigned char*)a.out;
    const bf16_t* PA = (const bf16_t*)(ws + WS_RA);
    bf16_t* cqkvn = (bf16_t*)(dob + DO_CQKV); bf16_t* gsilu = (bf16_t*)(dob + DO_GS); bf16_t* xqn = (bf16_t*)(dob + DO_XQ); bf16_t* vretT = (bf16_t*)(dob + DO_VRT);
    bf16_t* qret = (bf16_t*)(ws + WS_QRET); bf16_t* kret = (bf16_t*)(ws + WS_KRET); bf16_t* kretT = (bf16_t*)(ws + WS_KRETT); bf16_t* krb = (bf16_t*)(ws + WS_KR);
    const f32x2* cs64 = (const f32x2*)(ws + WS_CS64);
    const float xq_scale = 0.08838834764831845f * LOG2E;
    for (int it = bx; it < 512 + 256; it += G) {
        __syncthreads();
        if (it < 512) {
            const int t0 = it * 64, b = t0 >> 12, s0 = t0 & 4095;
            for (int i = 0; i < 8; i += 2) {
                u32x4 wA[2], wV[2], wK[2]; u32x2 wR[2];
#pragma unroll
                for (int j = 0; j < 2; ++j) { const int t = t0 + wave * 8 + i + j; const bf16_t* row = PA + (size_t)t * NPA;
                    wA[j] = *(const u32x4*)(row + 8 * lane); wV[j] = *(const u32x4*)(row + 1024 + 8 * lane);
                    wK[j] = *(const u32x4*)(row + 2560 + 8 * (lane & 3));
                    wR[j] = *(const u32x2*)(kret + (size_t)t * 256 + 4 * lane); }
#pragma unroll
                for (int j = 0; j < 2; ++j) { const int tl = wave * 8 + i + j, t = t0 + tl;
                    { float f[8]; unpack8(wA[j], f); float ss = 0.f;
#pragma unroll
                      for (int e = 0; e < 8; ++e) ss += f[e] * f[e];
                      const float sq = wave_sum(lane < 48 ? ss : 0.f), skv = wave_sum(lane >= 48 ? ss : 0.f);
                      const float rinv = lane < 48 ? rsq(sq * (1.f / 384.f) + EPS_) : rsq(skv * (1.f / 128.f) + EPS_);
                      const float* gp = lane < 48 ? a.mla_q_norm_g + 8 * lane : a.mla_kv_norm_g + 8 * (lane - 48);
#pragma unroll
                      for (int e = 0; e < 8; ++e) f[e] *= rinv * gp[e];
                      *(u32x4*)(cqkvn + (size_t)t * 512 + 8 * lane) = pack8(f); }
                    if (lane < 4) *(u32x4*)(krb + (size_t)t * 32 + 8 * lane) = wK[j];
                    *(LAS u32x4*)(lds + tl * P2_VT_PITCH + tr_slot(tl, lane) * 16) = wV[j];
                    *(LAS u32x2*)(lds + P2_KT_OFF + tl * P2_KT_PITCH + tr_slot(tl, lane >> 1) * 16 + (lane & 1) * 8) = wR[j];
                }
            }
            __syncthreads();
            tr_store_cols(lds, P2_VT_PITCH, 512, vretT + (size_t)b * 512 * S_, S_, s0);
            tr_store_cols(lds + P2_KT_OFF, P2_KT_PITCH, 256, kretT + (size_t)b * 256 * S_, S_, s0);
        } else {
            const int m0 = (it - 512) * 8, b = m0 >> 8, ms0 = m0 & 255;
            const bf16_t* KVM = (const bf16_t*)(ws + WS_KVM); bf16_t* kx = (bf16_t*)(ws + WS_KX); bf16_t* vxT = (bf16_t*)(ws + WS_VXT);
            for (int i = 0; i < 1; ++i) {
                const int tl = wave + i, mrow = m0 + tl; const bf16_t* row = KVM + (size_t)mrow * 1024;
#pragma unroll
                for (int half = 0; half < 2; ++half) {
                    const int ci = lane + 64 * half, h = ci >> 5, wi = ci & 31;
                    const u32x4 w = *(const u32x4*)(row + 8 * ci); float f[8]; unpack8(w, f); float ss = 0.f;
#pragma unroll
                    for (int e = 0; e < 8; ++e) ss += f[e] * f[e];
                    const float tot = sum16(ss);
                    if (wi < 16) { const float rinv = rsq(tot * (1.f / 128.f) + EPS_); const float* gp = a.x_kn_g + 8 * wi; const float* gq = a.x_qn_g + 8 * wi;
#pragma unroll
                        for (int e = 0; e < 8; ++e) f[e] *= rinv * gp[e] * gq[e];
                        *(u32x4*)(kx + ((size_t)(b * 4 + h) * 256 + (ms0 + tl)) * 128 + 8 * wi) = pack8(f); }
                    else *(LAS u32x4*)(lds + tl * P2_VT_PITCH + tr_slot(tl, h * 16 + wi - 16) * 16) = w;
                }
            }
            __syncthreads();
            tr_store_cols(lds, P2_VT_PITCH, 512, vxT + (size_t)b * 512 * MEM_, MEM_, ms0, 1);
        }
    }
}

__device__ __forceinline__ void p3_ret_incr(const Args& a) {
    const int tid = threadIdx.x, lane = tid & 63, r32 = lane & 31, hi = lane >> 5, w = __builtin_amdgcn_readfirstlane(tid >> 6);
    const bf16_t* vretT = (const bf16_t*)((unsigned char*)a.out + DO_VRT); const bf16_t* kretT = (const bf16_t*)(a.ws + WS_KRETT);
    float* incr = (float*)(a.ws + WS_INCR);
    const int mb = w >> 1, nb = w & 1;
    for (int it = blockIdx.x; it < 1024; it += gridDim.x) {
        const int bh = it >> 5, c = it & 31, h = bh & 3; const float lg = a.lg2g[h];
        const bf16_t* vp = vretT + ((size_t)bh * 128 + mb * 32 + r32) * S_ + c * 128 + hi * 8;
        const bf16_t* kp = kretT + ((size_t)bh * 64 + nb * 32 + r32) * S_ + c * 128 + hi * 8;
        f32x16 acc = F16Z;
#pragma unroll
        for (int ks = 0; ks < 8; ++ks) {
            const bf16x8 av = *(const bf16x8*)(vp + ks * 16);
            const u32x4 kw = *(const u32x4*)(kp + ks * 16); float f[8]; unpack8(kw, f);
#pragma unroll
            for (int e = 0; e < 8; ++e) f[e] *= ex2(lg * (float)(127 - (ks * 16 + hi * 8 + e)));
            const u32x4 ks4 = pack8(f);
            acc = mfma32(av, __builtin_bit_cast(bf16x8, ks4), acc);
        }
        float* op = incr + (size_t)it * 8192 + (size_t)(mb * 32) * 64 + nb * 32 + r32;
#pragma unroll
        for (int r = 0; r < 16; ++r) op[(size_t)crow(r, hi) * 64] = acc[r];
    }
}

__device__ __forceinline__ void p4_post_up(const Args& a, LAS unsigned char* lds) {
    const int tid = threadIdx.x, lane = tid & 63, wave = tid >> 6, G = gridDim.x, bx = blockIdx.x;
    unsigned char* ws = a.ws;
    bf16_t* UP = (bf16_t*)(ws + WS_UP); bf16_t* vmT = (bf16_t*)(ws + WS_VMT); const bf16_t* krb = (const bf16_t*)(ws + WS_KR);
    const f32x2* cs32 = (const f32x2*)(ws + WS_CS32);
    const float q_scale = 0.10206207261596577f * LOG2E;
    const bool flip4 = ((bx >> 3) & 1) != 0;
#pragma unroll 1
    for (int st = 0; st < 2; ++st) {
      if ((flip4 ? 1 - st : st) == 0) {
    { float* __restrict__ incr = (float*)(ws + WS_INCR);
      for (int e = bx * 512 + tid; e < 32 * 8192; e += G * 512) {
          const int bh = e >> 13, el = e & 8191, h = bh & 3; const float cd = ex2(128.f * a.lg2g[h]);
          float* p = incr + (size_t)bh * 32 * 8192 + el; float r = 0.f;
          float inc[32];
#pragma unroll
          for (int c = 0; c < 32; ++c) inc[c] = p[(size_t)c * 8192];
#pragma unroll
          for (int c = 0; c < 32; ++c) { p[(size_t)c * 8192] = r; r = cd * r + inc[c]; }
      } }
      } else {
    for (int it = bx; it < 512; it += G) {
        const int t0 = it * 64, b = t0 >> 12, s0 = t0 & 4095;
        __syncthreads();
        for (int i = 0; i < 8; ++i) { const int tl = wave * 8 + i, t = t0 + tl;
            *(LAS u32x4*)(lds + tl * P2_VT_PITCH + tr_slot(tl, lane) * 16) = *(const u32x4*)(UP + (size_t)t * NUP + 768 + (lane >> 3) * 128 + 64 + (lane & 7) * 8); }
        __syncthreads();
        tr_store_cols(lds, P2_VT_PITCH, 512, vmT + (size_t)b * 512 * S_, S_, s0);
        __syncthreads();
        { const int hh = lane >> 3, j = lane & 7; const float* gk = a.mla_kn_g;
          float gn[8];
#pragma unroll
          for (int e = 0; e < 8; ++e) gn[e] = gk[8 * j + e];
          const float g64a = gk[64 + 2 * j], g64b = gk[65 + 2 * j], g80a = gk[80 + 2 * j], g80b = gk[81 + 2 * j];
          for (int ib = 0; ib < 8; ib += 4) {
              u32x4 nw[4]; unsigned ka[4], kb[4]; f32x4 csw[4]; int pc[4];
#pragma unroll
              for (int q = 0; q < 4; ++q) { const int t = t0 + wave * 8 + ib + q; const int p = a.pos[t]; pc[q] = p < 0 ? 0 : (p >= NPOS ? NPOS - 1 : p); }
#pragma unroll
              for (int q = 0; q < 4; ++q) { const int t = t0 + wave * 8 + ib + q; const bf16_t* kp = UP + (size_t)t * NUP + 768 + hh * 128;
                  nw[q] = *(const u32x4*)(kp + 8 * j); ka[q] = *(const unsigned*)(krb + (size_t)t * 32 + 2 * j); kb[q] = *(const unsigned*)(krb + (size_t)t * 32 + 16 + 2 * j);
                  csw[q] = *(const f32x4*)(cs32 + (size_t)pc[q] * 16 + 2 * j); }
#pragma unroll
              for (int q = 0; q < 4; ++q) { const int t = t0 + wave * 8 + ib + q; bf16_t* kp = UP + (size_t)t * NUP + 768 + hh * 128;
                  float n[8]; unpack8(nw[q], n);
                  const float r1a = bflo(ka[q]), r1b = bfhi(ka[q]), r2a = bflo(kb[q]), r2b = bfhi(kb[q]);
                  float ss = r1a * r1a + r1b * r1b + r2a * r2a + r2b * r2b;
#pragma unroll
                  for (int e = 0; e < 8; ++e) ss += n[e] * n[e];
                  ss += __shfl_xor(ss, 1); ss += __shfl_xor(ss, 2); ss += __shfl_xor(ss, 4);
                  const float rinv = rsq(ss * (1.f / 96.f) + EPS_);
#pragma unroll
                  for (int e = 0; e < 8; ++e) n[e] *= rinv * gn[e];
                  const float y1a = r1a * rinv * g64a, y1b = r1b * rinv * g64b, y2a = r2a * rinv * g80a, y2b = r2b * rinv * g80b;
                  const f32x4 c = csw[q];
                  *(u32x4*)(kp + 8 * j) = pack8(n);
                  *(unsigned*)(kp + 64 + 2 * j) = pk2(y1a * c.x - y2a * c.y, y1b * c.z - y2b * c.w);
                  *(unsigned*)(kp + 80 + 2 * j) = pk2(y1a * c.y + y2a * c.x, y1b * c.w + y2b * c.z); }
          } }
    }
      }
    }
}

__device__ __forceinline__ int opaque_tid() { int t = threadIdx.x; asm volatile("" : "+v"(t)); return t; }
__device__ __forceinline__ void swap32u(unsigned& x, unsigned& y) { asm("s_nop 1\n\tv_permlane32_swap_b32 %0, %1\n\ts_nop 1" : "+v"(x), "+v"(y)); }
__device__ __forceinline__ float vmax3(float a, float b, float c) { float r; asm("v_max3_f32 %0, %1, %2, %3" : "=v"(r) : "v"(a), "v"(b), "v"(c)); return r; }
__device__ __forceinline__ bf16x8 vfrag(const LAS unsigned char* p) { const u32x2 lo = *(const LAS u32x2*)p, hi = *(const LAS u32x2*)(p + 16); return __builtin_bit_cast(bf16x8, (u32x4){lo.x, lo.y, hi.x, hi.y}); }
__device__ __forceinline__ bf16x8 pfrag(const f32x16& p, const int s) { return __builtin_bit_cast(bf16x8, (u32x4){pk2(p[8 * s], p[8 * s + 1]), pk2(p[8 * s + 2], p[8 * s + 3]), pk2(p[8 * s + 4], p[8 * s + 5]), pk2(p[8 * s + 6], p[8 * s + 7])}); }

constexpr int ML_KP = 208, ML_VP = 136, ML_KB = 64 * ML_KP, ML_VB = 64 * ML_VP, ML_VOFF = 2 * ML_KB;
__device__ __forceinline__ void mla_item(const Args& a, LAS unsigned char* lds, int b, int h, int qb) {
    const int tid = opaque_tid(), lane = tid & 63, r32 = lane & 31, hi = lane >> 5, w = __builtin_amdgcn_readfirstlane(tid >> 6);
    const bf16_t* UP = (const bf16_t*)(a.ws + WS_UP); const bf16_t* vmT = (const bf16_t*)(a.ws + WS_VMT); bf16_t* omla = (bf16_t*)(a.ws + WS_OMLA);
    const size_t tb = (size_t)b * S_; const int q0 = qb * 256 + w * 32;
    bf16x8 qf[6];
    {
        const bf16_t* qp = UP + (tb + q0 + r32) * NUP + h * 96 + hi * 8;
        const int pq = a.pos[tb + q0 + r32]; const int pc = pq < 0 ? 0 : (pq >= NPOS ? NPOS - 1 : pq);
        const f32x2* csp = (const f32x2*)(a.ws + WS_CS32) + (size_t)pc * 16 + 8 * hi;
        u32x4 qw[6]; f32x4 csw[4];
#pragma unroll
        for (int ks = 0; ks < 6; ++ks) qw[ks] = *(const u32x4*)(qp + ks * 16);
#pragma unroll
        for (int i = 0; i < 4; ++i) csw[i] = *(const f32x4*)(csp + 2 * i);
        float qv[6][8]; float ss = 0.f;
#pragma unroll
        for (int ks = 0; ks < 6; ++ks) { unpack8(qw[ks], qv[ks]);
#pragma unroll
            for (int e = 0; e < 8; ++e) ss += qv[ks][e] * qv[ks][e]; }
        const float rinv = rsq(xsum32(ss) * (1.f / 96.f) + EPS_) * (0.10206207261596577f * LOG2E);
        const float* gq = a.mla_qn_g + 8 * hi;
#pragma unroll
        for (int ks = 0; ks < 6; ++ks)
#pragma unroll
            for (int e = 0; e < 8; ++e) qv[ks][e] *= rinv * gq[16 * ks + e];
#pragma unroll
        for (int e = 0; e < 8; ++e) { const float c = csw[e >> 1][2 * (e & 1)], sn = csw[e >> 1][2 * (e & 1) + 1], y1 = qv[4][e], y2 = qv[5][e];
            qv[4][e] = y1 * c - y2 * sn; qv[5][e] = y1 * sn + y2 * c; }
#pragma unroll
        for (int ks = 0; ks < 6; ++ks) qf[ks] = __builtin_bit_cast(bf16x8, pack8(qv[ks]));
    }
    f32x16 o0 = F16Z, o1 = F16Z, negm = F16Z, lacc = F16Z; float l = 0.f; bool first = true;
    const bf16x8 ones = (bf16x8){0x3F80, 0x3F80, 0x3F80, 0x3F80, 0x3F80, 0x3F80, 0x3F80, 0x3F80};
    const int nkt = 4 * (qb + 1);
    const bf16_t* kg = UP + tb * NUP + 768 + h * 128; const bf16_t* vg = vmT + ((size_t)(b * 8 + h) * 64) * S_;
    const int kc0r = tid / 12, kc0c = tid % 12, kc1r = (tid + 512) / 12, kc1c = (tid + 512) % 12; const bool k1ok = tid < 256;
    const int vr_ = tid >> 3, vc_ = tid & 7;
    u32x4 kr0, kr1 = (u32x4){0u, 0u, 0u, 0u}, vr;
#define ML_LOAD(kt) do { kr0 = *(const u32x4*)(kg + (size_t)(64 * (kt) + kc0r) * NUP + 8 * kc0c); if (k1ok) kr1 = *(const u32x4*)(kg + (size_t)(64 * (kt) + kc1r) * NUP + 8 * kc1c); \
        vr = *(const u32x4*)(vg + (size_t)vr_ * S_ + 64 * (kt) + 8 * vc_); } while (0)
#define ML_STORE(buf) do { *(LAS u32x4*)(lds + (buf) * ML_KB + kc0r * ML_KP + kc0c * 16) = kr0; if (k1ok) *(LAS u32x4*)(lds + (buf) * ML_KB + kc1r * ML_KP + kc1c * 16) = kr1; \
        *(LAS u32x2*)(lds + ML_VOFF + (buf) * ML_VB + vr_ * ML_VP + vc_ * 16) = (u32x2){vr.x, vr.y}; *(LAS u32x2*)(lds + ML_VOFF + (buf) * ML_VB + vr_ * ML_VP + vc_ * 16 + 8) = (u32x2){vr.z, vr.w}; } while (0)
    __syncthreads();
    ML_LOAD(0); ML_STORE(0);
    __syncthreads();
    for (int kt = 0; kt < nkt; ++kt) {
        const int buf = kt & 1;
        if (kt + 1 < nkt) ML_LOAD(kt + 1);
        if (64 * kt <= q0 + 31) {
            const LAS unsigned char* Kb = lds + buf * ML_KB + r32 * ML_KP + hi * 16; const LAS unsigned char* Vb = lds + ML_VOFF + buf * ML_VB + r32 * ML_VP + hi * 8;
            f32x16 p0 = negm, p1 = negm;
            __builtin_amdgcn_s_setprio(1);
#pragma unroll
            for (int ks = 0; ks < 6; ++ks) { const bf16x8 k0 = *(const LAS bf16x8*)(Kb + ks * 32), k1 = *(const LAS bf16x8*)(Kb + 32 * ML_KP + ks * 32);
                p0 = mfma32(k0, qf[ks], p0); p1 = mfma32(k1, qf[ks], p1); }
            __builtin_amdgcn_s_setprio(0);
            if (64 * kt + 63 > q0) {
                const int qa = q0 + r32, kb0 = 64 * kt + 4 * hi;
#pragma unroll
                for (int r = 0; r < 16; ++r) { const int kv = kb0 + (r & 3) + 8 * (r >> 2); if (kv > qa) p0[r] = -1e30f; if (kv + 32 > qa) p1[r] = -1e30f; }
            }
            float tm = vmax3(p0[0], p0[1], p0[2]), tn = vmax3(p1[0], p1[1], p1[2]);
#pragma unroll
            for (int r = 3; r < 15; r += 2) { tm = vmax3(tm, p0[r], p0[r + 1]); tn = vmax3(tn, p1[r], p1[r + 1]); }
            tm = vmax3(tm, p0[15], tn); tm = vmax3(tm, p1[15], tm);
            tm = xmax32(tm);
            if (first || __any(tm > 8.f)) {
                const float d = first ? tm : fmaxf(tm, 0.f), al = first ? 0.f : ex2(-d);
                l = (l + lacc[0]) * al; lacc = F16Z;
#pragma unroll
                for (int r = 0; r < 16; ++r) { o0[r] *= al; o1[r] *= al; p0[r] -= d; p1[r] -= d; negm[r] -= d; }
                first = false;
            }
#pragma unroll
            for (int r = 0; r < 16; ++r) { p0[r] = ex2(p0[r]); p1[r] = ex2(p1[r]); }
            __builtin_amdgcn_s_setprio(1);
#pragma unroll
            for (int s = 0; s < 2; ++s) {
                const bf16x8 pa = pfrag(p0, s), pb = pfrag(p1, s);
                lacc = mfma32(ones, pa, lacc); lacc = mfma32(ones, pb, lacc);
                o0 = mfma32(vfrag(Vb + (16 * s) * 2), pa, o0);            o1 = mfma32(vfrag(Vb + 32 * ML_VP + (16 * s) * 2), pa, o1);
                o0 = mfma32(vfrag(Vb + (32 + 16 * s) * 2), pb, o0);       o1 = mfma32(vfrag(Vb + 32 * ML_VP + (32 + 16 * s) * 2), pb, o1);
            }
            __builtin_amdgcn_s_setprio(0);
        }
        if (kt + 1 < nkt) ML_STORE(buf ^ 1);
        __syncthreads();
    }
#undef ML_LOAD
#undef ML_STORE
    const float inv = (DBG_ZERO & 1) ? 0.f : ((DBG_ZERO & 16) ? 2.f : 1.f) * rcp(l + lacc[0]);
    bf16_t* op = omla + (tb + q0 + r32) * 512 + h * 64;
#pragma unroll
    for (int gp = 0; gp < 2; ++gp) {
        unsigned ax = pk2(o0[8 * gp] * inv, o0[8 * gp + 1] * inv), ay = pk2(o0[8 * gp + 2] * inv, o0[8 * gp + 3] * inv), bx_ = pk2(o0[8 * gp + 4] * inv, o0[8 * gp + 5] * inv), by_ = pk2(o0[8 * gp + 6] * inv, o0[8 * gp + 7] * inv);
        swap32u(ax, bx_); swap32u(ay, by_);
        *(u32x4*)(op + 8 * (2 * gp + hi)) = (u32x4){ax, ay, bx_, by_};
        unsigned cx = pk2(o1[8 * gp] * inv, o1[8 * gp + 1] * inv), cy = pk2(o1[8 * gp + 2] * inv, o1[8 * gp + 3] * inv), dx = pk2(o1[8 * gp + 4] * inv, o1[8 * gp + 5] * inv), dy = pk2(o1[8 * gp + 6] * inv, o1[8 * gp + 7] * inv);
        swap32u(cx, dx); swap32u(cy, dy);
        *(u32x4*)(op + 32 + 8 * (2 * gp + hi)) = (u32x4){cx, cy, dx, dy};
    }
}

constexpr int MX_KP = 272, MX_VP = 520, MX_VOFF = 256 * MX_KP;
__device__ __forceinline__ void mem_load_kv(const Args& a, LAS unsigned char* lds, int bh) {
    const bf16_t* kx = (const bf16_t*)(a.ws + WS_KX) + (size_t)bh * 256 * 128; const bf16_t* vxT = (const bf16_t*)(a.ws + WS_VXT) + (size_t)bh * 128 * 256;
    const int tid = opaque_tid();
#pragma unroll
    for (int i = 0; i < 8; ++i) { const int c = tid + 512 * i;
        { const int row = c >> 4, cc = c & 15; *(LAS u32x4*)(lds + row * MX_KP + cc * 16) = *(const u32x4*)(kx + (size_t)row * 128 + 8 * cc); }
        { const int row = c >> 5, cc = c & 31; const u32x4 v = *(const u32x4*)(vxT + (size_t)row * 256 + 8 * cc);
          *(LAS u32x2*)(lds + MX_VOFF + row * MX_VP + cc * 16) = (u32x2){v.x, v.y}; *(LAS u32x2*)(lds + MX_VOFF + row * MX_VP + cc * 16 + 8) = (u32x2){v.z, v.w}; } }
}
__device__ __forceinline__ void mem_item(const Args& a, LAS unsigned char* lds, int b, int h, int qb) {
    const int tid = opaque_tid(), lane = tid & 63, r32 = lane & 31, hi = lane >> 5, w = __builtin_amdgcn_readfirstlane(tid >> 6);
    bf16_t* xqn = (bf16_t*)((unsigned char*)a.out + DO_XQ);
    const size_t tb = (size_t)b * S_; const int q0 = qb * 256 + w * 32;
    bf16_t* qrow = xqn + (tb + q0 + r32) * 512 + h * 128;
    bf16x8 qf[8];
    { const float qsc = rsq(((const float*)(a.ws + WS_SSX))[(tb + q0 + r32) * 4 + h] * (1.f / 128.f) + EPS_) * (0.08838834764831845f * LOG2E);
#pragma unroll
      for (int ks = 0; ks < 8; ++ks) { const u32x4 w = *(const u32x4*)(qrow + hi * 8 + ks * 16); float f[8]; unpack8(w, f);
#pragma unroll
          for (int e = 0; e < 8; ++e) f[e] *= qsc;
          qf[ks] = __builtin_bit_cast(bf16x8, pack8(f)); } }
    f32x16 o[4] = {F16Z, F16Z, F16Z, F16Z}; float m = -1e30f, l = 0.f;
#pragma unroll 1
    for (int kt = 0; kt < 4; ++kt) {
        const LAS unsigned char* Kb = lds + (64 * kt + r32) * MX_KP + hi * 16; const LAS unsigned char* Vb = lds + MX_VOFF + r32 * MX_VP + (64 * kt + 4 * hi) * 2;
        f32x16 p0 = F16Z, p1 = F16Z;
        __builtin_amdgcn_s_setprio(1);
#pragma unroll
        for (int ks = 0; ks < 8; ++ks) { const bf16x8 k0 = *(const LAS bf16x8*)(Kb + ks * 32), k1 = *(const LAS bf16x8*)(Kb + 32 * MX_KP + ks * 32);
            p0 = mfma32(k0, qf[ks], p0); p1 = mfma32(k1, qf[ks], p1); }
        __builtin_amdgcn_s_setprio(0);
        float tm = vmax3(p0[0], p0[1], p0[2]), tn = vmax3(p1[0], p1[1], p1[2]);
#pragma unroll
        for (int r = 3; r < 15; r += 2) { tm = vmax3(tm, p0[r], p0[r + 1]); tn = vmax3(tn, p1[r], p1[r + 1]); }
        tm = vmax3(tm, p0[15], tn); tm = vmax3(tm, p1[15], tm);
        tm = xmax32(tm);
        const float mn = fmaxf(m, tm), al = ex2(m - mn); m = mn;
        float ps = 0.f;
#pragma unroll
        for (int r = 0; r < 16; ++r) { p0[r] = ex2(p0[r] - mn); p1[r] = ex2(p1[r] - mn); ps += p0[r] + p1[r]; }
        l = l * al + ps;
#pragma unroll
        for (int db = 0; db < 4; ++db)
#pragma unroll
            for (int r = 0; r < 16; ++r) o[db][r] *= al;
        __builtin_amdgcn_s_setprio(1);
#pragma unroll
        for (int s = 0; s < 2; ++s) {
            const bf16x8 pa = pfrag(p0, s), pb = pfrag(p1, s);
#pragma unroll
            for (int db = 0; db < 4; ++db) { o[db] = mfma32(vfrag(Vb + db * 32 * MX_VP + (16 * s) * 2), pa, o[db]); o[db] = mfma32(vfrag(Vb + db * 32 * MX_VP + (32 + 16 * s) * 2), pb, o[db]); }
        }
        __builtin_amdgcn_s_setprio(0);
    }
    const float inv = (DBG_ZERO & 2) ? 0.f : ((DBG_ZERO & 32) ? 2.f : 1.f) * rcp(xsum32(l));
#pragma unroll
    for (int db = 0; db < 4; ++db)
#pragma unroll
        for (int gp = 0; gp < 2; ++gp) {
            unsigned ax = pk2(o[db][8 * gp] * inv, o[db][8 * gp + 1] * inv), ay = pk2(o[db][8 * gp + 2] * inv, o[db][8 * gp + 3] * inv), bx_ = pk2(o[db][8 * gp + 4] * inv, o[db][8 * gp + 5] * inv), by_ = pk2(o[db][8 * gp + 6] * inv, o[db][8 * gp + 7] * inv);
            swap32u(ax, bx_); swap32u(ay, by_);
            *(u32x4*)(qrow + 32 * db + 8 * (2 * gp + hi)) = (u32x4){ax, ay, bx_, by_}; }
}

constexpr int RT_KP = 144, RT_VP = 520, RT_VOFF = 256 * RT_KP, RT_ROFF = RT_VOFF + 128 * RT_VP;
__device__ __forceinline__ void ret_item(const Args& a, LAS unsigned char* lds, int b, int h, int cp) {
    const int tid = opaque_tid(), lane = tid & 63, r32 = lane & 31, hi = lane >> 5, w = __builtin_amdgcn_readfirstlane(tid >> 6);
    const bf16_t* qret = (const bf16_t*)(a.ws + WS_QRET); const bf16_t* kret = (const bf16_t*)(a.ws + WS_KRET);
    const bf16_t* vretT = (const bf16_t*)((unsigned char*)a.out + DO_VRT); bf16_t* gs = (bf16_t*)((unsigned char*)a.out + DO_GS); const float* Rp = (const float*)(a.ws + WS_INCR);
    const size_t tb = (size_t)b * S_; const int bh = b * 4 + h, sbase = cp * 256; const float lg = a.lg2g[h];
    __syncthreads();
    const int ci = w >> 2, qi = w & 3, iq = 32 * qi + r32;
    const size_t tq = tb + sbase + 128 * ci + iq;
    u32x4 kk[4], vv[8]; f32x4 rr[8];
#pragma unroll
    for (int i = 0; i < 4; ++i) { const int c = tid + 512 * i; const int row = c >> 3, cc = c & 7; kk[i] = *(const u32x4*)(kret + (tb + sbase + row) * 256 + h * 64 + 8 * cc); }
#pragma unroll
    for (int i = 0; i < 8; ++i) { const int c = tid + 512 * i; const int row = c >> 5, cc = c & 31; vv[i] = *(const u32x4*)(vretT + ((size_t)bh * 128 + row) * S_ + sbase + 8 * cc); }
    { const f32x4* R4 = (const f32x4*)(Rp + ((size_t)bh * 32 + 2 * cp) * 8192);
#pragma unroll
      for (int i = 0; i < 8; ++i) rr[i] = R4[tid + 512 * i]; }
    bf16x8 qf[4];
#pragma unroll
    for (int ks = 0; ks < 4; ++ks) qf[ks] = *(const bf16x8*)(qret + tq * 256 + h * 64 + hi * 8 + ks * 16);
    bf16_t* grow = gs + tq * 512 + h * 128;
    u32x4 gL[4][2];
#pragma unroll
    for (int db = 0; db < 4; ++db)
#pragma unroll
        for (int gp = 0; gp < 2; ++gp) gL[db][gp] = *(const u32x4*)(grow + 32 * db + 8 * (2 * gp + hi));
#pragma unroll
    for (int i = 0; i < 4; ++i) { const int c = tid + 512 * i; const int row = c >> 3, cc = c & 7; *(LAS u32x4*)(lds + row * RT_KP + cc * 16) = kk[i]; }
#pragma unroll
    for (int i = 0; i < 8; ++i) { const int c = tid + 512 * i; const int row = c >> 5, cc = c & 31;
        *(LAS u32x2*)(lds + RT_VOFF + row * RT_VP + cc * 16) = (u32x2){vv[i].x, vv[i].y}; *(LAS u32x2*)(lds + RT_VOFF + row * RT_VP + cc * 16 + 8) = (u32x2){vv[i].z, vv[i].w}; }
#pragma unroll
    for (int i = 0; i < 8; ++i) { const int c = tid + 512 * i; const int row = c >> 4, col = 4 * (c & 15);
        *(LAS u32x2*)(lds + RT_ROFF + row * RT_KP + col * 2) = (u32x2){pk2(rr[i].x, rr[i].y), pk2(rr[i].z, rr[i].w)}; }
    __syncthreads();
    f32x16 o[4] = {F16Z, F16Z, F16Z, F16Z};
    { const LAS unsigned char* Rl = lds + RT_ROFF + (128 * ci + r32) * RT_KP + hi * 16;
#pragma unroll
      for (int db = 0; db < 4; ++db)
#pragma unroll
          for (int ks = 0; ks < 4; ++ks) o[db] = mfma32(*(const LAS bf16x8*)(Rl + (32 * db) * RT_KP + ks * 32), qf[ks], o[db]);
      const float xi = ex2(lg * (float)(iq + 1));
#pragma unroll
      for (int db = 0; db < 4; ++db)
#pragma unroll
          for (int r = 0; r < 16; ++r) o[db][r] *= xi; }
#pragma unroll 1
    for (int kt = 0; kt < 2; ++kt) {
        if (64 * kt > 32 * qi + 31) break;
        const LAS unsigned char* Kb = lds + (128 * ci + 64 * kt + r32) * RT_KP + hi * 16; const LAS unsigned char* Vb = lds + RT_VOFF + r32 * RT_VP + (128 * ci + 64 * kt + 4 * hi) * 2;
        f32x16 p0 = F16Z, p1 = F16Z;
#pragma unroll
        for (int ks = 0; ks < 4; ++ks) { const bf16x8 k0 = *(const LAS bf16x8*)(Kb + ks * 32), k1 = *(const LAS bf16x8*)(Kb + 32 * RT_KP + ks * 32);
            p0 = mfma32(k0, qf[ks], p0); p1 = mfma32(k1, qf[ks], p1); }
#pragma unroll
        for (int r = 0; r < 16; ++r) { const int d0 = iq - (64 * kt + crow(r, hi)), d1 = d0 - 32;
            p0[r] = d0 >= 0 ? p0[r] * ex2(lg * (float)d0) : 0.f; p1[r] = d1 >= 0 ? p1[r] * ex2(lg * (float)d1) : 0.f; }
#pragma unroll
        for (int s = 0; s < 2; ++s) {
            const bf16x8 pa = pfrag(p0, s), pb = pfrag(p1, s);
#pragma unroll
            for (int db = 0; db < 4; ++db) { o[db] = mfma32(vfrag(Vb + db * 32 * RT_VP + (16 * s) * 2), pa, o[db]); o[db] = mfma32(vfrag(Vb + db * 32 * RT_VP + (32 + 16 * s) * 2), pb, o[db]); }
        }
    }
    float ss = 0.f;
#pragma unroll
    for (int db = 0; db < 4; ++db)
#pragma unroll
        for (int r = 0; r < 16; ++r) ss += o[db][r] * o[db][r];
    const float rinv = ((DBG_ZERO & 4) || ((DBG_ZERO & 256) && cp == 0 && ci == 0 && qi == 0)) ? 0.f : ((DBG_ZERO & 128) ? 1.08f : 1.f) * rsq(xsum32(ss) * (1.f / 128.f) + EPS_);
    const float* gn = a.ret_gn_g + h * 128;
    if (DBG_CHECK && ((int)(tq & 31) == 7)) { float* dbg = (float*)(a.ws + 498 * MiB) + ((size_t)(tq >> 5)) * 512 + h * 128;
#pragma unroll
        for (int db = 0; db < 4; ++db)
#pragma unroll
            for (int r = 0; r < 16; ++r) dbg[32 * db + crow(r, hi)] = o[db][r] * rinv * gn[32 * db + crow(r, hi)]; }
#pragma unroll
    for (int db = 0; db < 4; ++db)
#pragma unroll
        for (int gp = 0; gp < 2; ++gp) {
            unsigned lx = gL[db][gp].x, ly = gL[db][gp].y, lz = gL[db][gp].z, lw = gL[db][gp].w; swap32u(lx, lz); swap32u(ly, lw);
            u32x2 res[2];
#pragma unroll
            for (int q = 0; q < 2; ++q) { const int g = 2 * gp + q, dv = 32 * db + 8 * g + 4 * hi; const f32x4 gg = *(const f32x4*)(gn + dv); const unsigned g0 = q ? lz : lx, g1 = q ? lw : ly;
                res[q] = (u32x2){pk2(o[db][4 * g] * rinv * gg.x * bflo(g0), o[db][4 * g + 1] * rinv * gg.y * bfhi(g0)), pk2(o[db][4 * g + 2] * rinv * gg.z * bflo(g1), o[db][4 * g + 3] * rinv * gg.w * bfhi(g1))}; }
            unsigned ax = res[0].x, ay = res[0].y, bx_ = res[1].x, by_ = res[1].y; swap32u(ax, bx_); swap32u(ay, by_);
            *(u32x4*)(grow + 32 * db + 8 * (2 * gp + hi)) = (u32x4){ax, ay, bx_, by_}; }
}


__device__ __forceinline__ void dbg_ret_check(const Args& a) {
    const int tid = threadIdx.x, lane = tid & 63, wave = tid >> 6;
    const bf16_t* qret = (const bf16_t*)(a.ws + WS_QRET); const bf16_t* kret = (const bf16_t*)(a.ws + WS_KRET);
    const bf16_t* vretT = (const bf16_t*)((unsigned char*)a.out + DO_VRT); const float* dbg = (const float*)(a.ws + 498 * MiB);
    float worst = 0.f, sq_d = 0.f, sq_n = 0.f; int worst_inst = 0, nbad = 0;
    for (int inst = blockIdx.x * 8 + wave; inst < 4096; inst += gridDim.x * 8) {
        const int h = inst & 3, tk = inst >> 2;
        const size_t t = (size_t)tk * 32 + 7; const int b = (int)(t >> 12), i = (int)(t & 4095); const float lg = a.lg2g[h];
        const float qv = bf1(qret[t * 256 + h * 64 + lane]);
        float o0 = 0.f, o1 = 0.f;
        const bf16_t* v0 = vretT + ((size_t)(b * 4 + h) * 128 + lane) * S_; const bf16_t* v1 = v0 + (size_t)64 * S_;
        for (int j = 0; j <= i; ++j) {
            const float kv = bf1(kret[((size_t)b * S_ + j) * 256 + h * 64 + lane]);
            const float sc = wave_sum(qv * kv) * ex2(lg * (float)(i - j));
            o0 += sc * bf1(v0[j]); o1 += sc * bf1(v1[j]);
        }
        const float rinv = rsq(wave_sum(o0 * o0 + o1 * o1) * (1.f / 128.f) + EPS_);
        const float n0 = o0 * rinv * a.ret_gn_g[h * 128 + lane], n1 = o1 * rinv * a.ret_gn_g[h * 128 + 64 + lane];
        const float* d = dbg + (size_t)tk * 512 + h * 128;
        float er = fmaxf(fabsf(n0 - d[lane]), fabsf(n1 - d[64 + lane]));
        { const float dd = wave_sum((n0 - d[lane]) * (n0 - d[lane]) + (n1 - d[64 + lane]) * (n1 - d[64 + lane])), nn = wave_sum(n0 * n0 + n1 * n1); if (DBG_CHECK != 14 || i < 32) { sq_d += dd; sq_n += nn; } }
#pragma unroll
        for (int o = 1; o < 64; o <<= 1) er = fmaxf(er, __shfl_xor(er, o));
        const bool sel = DBG_CHECK == 10 ? (i < 32) : DBG_CHECK == 11 ? (i >= 32 && i < 64) : DBG_CHECK == 4 ? (((i >> 7) & 31) == 0) : (DBG_CHECK == 5 ? (h < 3) : (DBG_CHECK == 6 ? (((i >> 7) & 31) == 1) : true));
        if (sel && er > worst) { worst = er; worst_inst = inst; }
        if (er > 0.2f && lane == 0) ++nbad;
    }
    atomicMax((unsigned long long*)(a.ws + WS_CTL) + 32, ((unsigned long long)__builtin_bit_cast(unsigned, worst) << 32) | (unsigned)worst_inst);
    if (nbad) atomicAdd((unsigned*)(a.ws + WS_CTL) + 72, (unsigned)nbad);
    if (lane == 0) { atomicAdd((float*)(a.ws + WS_CTL) + 90, sq_d); atomicAdd((float*)(a.ws + WS_CTL) + 91, sq_n); }
}


__device__ __forceinline__ void dbg_ret_eval(const Args& a, int inst) {
    const int lane = threadIdx.x & 63;
    const bf16_t* qret = (const bf16_t*)(a.ws + WS_QRET); const bf16_t* kret = (const bf16_t*)(a.ws + WS_KRET);
    const bf16_t* vretT = (const bf16_t*)((unsigned char*)a.out + DO_VRT); const float* dbg = (const float*)(a.ws + 498 * MiB);
    const int h = inst & 3, tk = inst >> 2;
    const size_t t = (size_t)tk * 32 + 7; const int b = (int)(t >> 12), i = (int)(t & 4095); const float lg = a.lg2g[h];
    const float qv = bf1(qret[t * 256 + h * 64 + lane]);
    float o0 = 0.f, o1 = 0.f;
    const bf16_t* v0 = vretT + ((size_t)(b * 4 + h) * 128 + lane) * S_; const bf16_t* v1 = v0 + (size_t)64 * S_;
    for (int j = 0; j <= i; ++j) {
        const float kv = bf1(kret[((size_t)b * S_ + j) * 256 + h * 64 + lane]);
        const float sc = wave_sum(qv * kv) * ex2(lg * (float)(i - j));
        o0 += sc * bf1(v0[j]); o1 += sc * bf1(v1[j]);
    }
    const float rinv = rsq(wave_sum(o0 * o0 + o1 * o1) * (1.f / 128.f) + EPS_);
    const float n0 = o0 * rinv * a.ret_gn_g[h * 128 + lane], n1 = o1 * rinv * a.ret_gn_g[h * 128 + 64 + lane];
    const float* d = dbg + (size_t)tk * 512 + h * 128;
    const float e0 = fabsf(n0 - d[lane]), e1 = fabsf(n1 - d[64 + lane]);
    const float el = fmaxf(e0, e1); float em = el;
#pragma unroll
    for (int o = 1; o < 64; o <<= 1) em = fmaxf(em, __shfl_xor(em, o));
    if (el == em) { float* c = (float*)(a.ws + WS_CTL); c[80] = e0 >= e1 ? n0 : n1; c[81] = e0 >= e1 ? d[lane] : d[64 + lane]; c[82] = (float)(e0 >= e1 ? lane : 64 + lane); }
}

__device__ __forceinline__ void p5_mixers(const Args& a, LAS unsigned char* lds) {
    const int G = gridDim.x, bx = blockIdx.x;
    const bool flip = ((bx >> 3) & 1) != 0;
#pragma unroll 1
    for (int st = 0; st < 3; ++st) {
        const int kind = flip ? 2 - st : st;
        if (kind == 0) {
            for (int pi = bx; pi < 512; pi += G) { const int bh = pi >> 3, x = pi & 7; mla_item(a, lds, bh >> 3, bh & 7, 15 - x); mla_item(a, lds, bh >> 3, bh & 7, x); }
        } else if (kind == 1) {
            int cur = -1;
            for (int it = bx * 2; it < 512; it += G * 2)
                for (int j = 0; j < 2; ++j) { const int i2 = it + j, bh = i2 >> 4, qb = i2 & 15;
                    if (bh != cur) { __syncthreads(); mem_load_kv(a, lds, bh); __syncthreads(); cur = bh; }
                    mem_item(a, lds, bh >> 2, bh & 3, qb); }
        } else {
            for (int it = bx; it < 512; it += G) { const int bh = it >> 4, cp = it & 15; ret_item(a, lds, bh >> 2, bh & 3, cp); }
        }
    }
}

__device__ __forceinline__ unsigned fp4_code(float x, float is4) {
    const float y = fabsf(x) * is4;
    const unsigned c = y < 2.f ? (unsigned)rintf(y * 2.f) : (y < 4.f ? (unsigned)rintf(y) + 2u : (y <= 5.f ? 6u : 7u));
    return c | (x < 0.f ? 8u : 0u);
}
__device__ __forceinline__ void table_fp4(const Args& a, const float* __restrict__ src, unsigned char* dst, float* scl, const float* __restrict__ gmul) {
    const int tid = threadIdx.x, lane = tid & 63, wave = tid >> 6, G = gridDim.x, bx = blockIdx.x;
    f32x4 gm[4];
#pragma unroll
    for (int q = 0; q < 4; ++q) gm[q] = gmul ? *(const f32x4*)(gmul + lane * 16 + 4 * q) : (f32x4){1.f, 1.f, 1.f, 1.f};
    for (int row0 = (bx * 8 + wave) * 4; row0 < 16384; row0 += G * 8 * 4) {
        f32x4 pv[4][4];
#pragma unroll
        for (int u = 0; u < 4; ++u)
#pragma unroll
            for (int q = 0; q < 4; ++q) pv[u][q] = *(const f32x4*)(src + (size_t)(row0 + u) * 1024 + lane * 16 + 4 * q);
#pragma unroll
        for (int u = 0; u < 4; ++u)
#pragma unroll
            for (int q = 0; q < 4; ++q) pv[u][q] *= gm[q];
#pragma unroll
        for (int u = 0; u < 4; ++u) {
            float am = 0.f;
#pragma unroll
            for (int q = 0; q < 4; ++q) am = fmaxf(am, fmaxf(fmaxf(fabsf(pv[u][q].x), fabsf(pv[u][q].y)), fmaxf(fabsf(pv[u][q].z), fabsf(pv[u][q].w))));
#pragma unroll
            for (int o = 1; o < 64; o <<= 1) am = fmaxf(am, __shfl_xor(am, o));
            const float s4 = fmaxf(am, 1e-30f) * (1.f / 6.f), is4 = 1.f / s4;
            unsigned w0 = 0u, w1 = 0u;
#pragma unroll
            for (int q = 0; q < 2; ++q)
#pragma unroll
                for (int e = 0; e < 4; ++e) { w0 |= fp4_code(pv[u][q][e], is4) << (16 * q + 4 * e); w1 |= fp4_code(pv[u][2 + q][e], is4) << (16 * q + 4 * e); }
            *(u32x2*)(dst + (size_t)(lane >> 4) * (2 * MiB) + (size_t)(row0 + u) * 128 + (lane & 15) * 8) = (u32x2){w0, w1};
            if (lane == 0) scl[2 * (row0 + u)] = s4;
        }
    }
}

constexpr int PE_SP = 272;
constexpr int PE_TK = 0, PE_EX = 65536, PE_GT = 65536 + 16384;
__device__ __forceinline__ unsigned sortkey_hi(unsigned S, int n) { const unsigned m = (unsigned)((int)S >> 31); return (S ^ ((m & 0x7fff0000u) | 0x80000000u)) | (unsigned)(127 - n); }
__device__ __forceinline__ unsigned sortkey(unsigned b16, int n) { const unsigned k = (b16 & 0x8000u) ? (~b16 & 0xffffu) : (b16 | 0x8000u); return (k << 16) | (unsigned)(127 - n); }
__device__ __forceinline__ float keyval(unsigned key) { const unsigned k = key >> 16; const unsigned b = (k & 0x8000u) ? (k & 0x7fffu) : (~k & 0xffffu); return __builtin_bit_cast(float, b << 16); }


__device__ __forceinline__ void sort16_asc(unsigned (&v)[16]) {
#define CE_(i, j) do { const unsigned x_ = v[i], y_ = v[j]; v[i] = x_ < y_ ? x_ : y_; v[j] = x_ < y_ ? y_ : x_; } while (0)
    CE_(0,13); CE_(1,12); CE_(2,15); CE_(3,14); CE_(4,8); CE_(5,6); CE_(7,11); CE_(9,10);
    CE_(0,5); CE_(1,7); CE_(2,9); CE_(3,4); CE_(6,13); CE_(8,14); CE_(10,15); CE_(11,12);
    CE_(0,1); CE_(2,3); CE_(4,5); CE_(6,8); CE_(7,9); CE_(10,11); CE_(12,13); CE_(14,15);
    CE_(0,2); CE_(1,3); CE_(4,10); CE_(5,11); CE_(6,7); CE_(8,9); CE_(12,14); CE_(13,15);
    CE_(1,2); CE_(3,12); CE_(4,6); CE_(5,7); CE_(8,10); CE_(9,11); CE_(13,14);
    CE_(1,4); CE_(2,6); CE_(5,8); CE_(7,10); CE_(9,13); CE_(11,14);
    CE_(2,4); CE_(3,6); CE_(9,12); CE_(11,13);
    CE_(3,5); CE_(6,8); CE_(7,9); CE_(10,12);
    CE_(3,4); CE_(5,6); CE_(7,8); CE_(9,10); CE_(11,12);
    CE_(6,7); CE_(8,9);
#undef CE_
}
__device__ __forceinline__ void merge16_desc(unsigned (&c)[16]) {
#pragma unroll
    for (int j = 8; j >= 1; j >>= 1)
#pragma unroll
        for (int i = 0; i < 16; ++i) { const int l = i ^ j; if (l > i) { const unsigned x = c[i], y = c[l]; c[i] = x < y ? y : x; c[l] = x < y ? x : y; } }
}
__device__ __forceinline__ void top16_absorb(unsigned (&best)[16], unsigned (&grp)[16]) {
    sort16_asc(grp);
#pragma unroll
    for (int i = 0; i < 16; ++i) best[i] = best[i] > grp[i] ? best[i] : grp[i];
    merge16_desc(best);
}
__device__ __forceinline__ unsigned fsort(float x) { const unsigned u = __builtin_bit_cast(unsigned, x); return u ^ ((unsigned)((int)u >> 31) | 0x80000000u); }
__device__ __forceinline__ float funsort(unsigned k) { const unsigned u = (k & 0x80000000u) ? (k ^ 0x80000000u) : ~k; return __builtin_bit_cast(float, u); }

__device__ __forceinline__ void p11a_topk(const Args& a, LAS unsigned char* lds) {
    const int tid = threadIdx.x, lane = tid & 63, wave = __builtin_amdgcn_readfirstlane(tid >> 6), G = gridDim.x, bx = blockIdx.x;
    const bf16_t* PQ = (const bf16_t*)(a.ws + WS_PQ); const bf16_t* KEYS = (const bf16_t*)(a.ws + WS_KEYS);
    for (int tile = bx; tile < T_ / 32; tile += G) {
        const int t0 = tile * 32;
        __syncthreads();
        { const int r32 = lane & 31, hi = lane >> 5;
#pragma unroll 1
          for (int u = 0; u < 2; ++u) { const int hc = 2 * wave + u;
              bf16x8 qa[8];
              { const bf16_t* qp = PQ + (size_t)(t0 + r32) * 2048 + hc * 128 + 8 * hi;
#pragma unroll
                for (int ks = 0; ks < 8; ++ks) qa[ks] = *(const bf16x8*)(qp + 16 * ks); }
#pragma unroll
              for (int nb = 0; nb < 4; ++nb) { const bf16_t* kp = KEYS + (((size_t)hc * 4 + nb) * 8 * 64 + lane) * 8;
                  f32x16 acc = F16Z;
#pragma unroll
                  for (int ks = 0; ks < 8; ++ks) acc = mfma32(qa[ks], *(const bf16x8*)(kp + ks * 512), acc);
#pragma unroll
                  for (int r = 0; r < 16; r += 2) { const unsigned w = pk2(acc[r], acc[r + 1]);
                      *(LAS bf16_t*)(lds + (crow(r, hi) * 16 + hc) * PE_SP + (32 * nb + r32) * 2) = (bf16_t)(w & 0xffffu);
                      *(LAS bf16_t*)(lds + (crow(r + 1, hi) * 16 + hc) * PE_SP + (32 * nb + r32) * 2) = (bf16_t)(w >> 16); } } } }
        __syncthreads();
        unsigned tk[16];
        { const LAS unsigned char* rowp = lds + tid * PE_SP;
#pragma unroll 1
          for (int g = 0; g < 8; ++g) { const u32x4 w0 = *(const LAS u32x4*)(rowp + g * 32), w1 = *(const LAS u32x4*)(rowp + g * 32 + 16); const unsigned ww[8] = {w0.x, w0.y, w0.z, w0.w, w1.x, w1.y, w1.z, w1.w};
              unsigned grp[16];
#pragma unroll
              for (int e = 0; e < 16; ++e) grp[e] = sortkey_hi((e & 1) ? (ww[e >> 1] & 0xffff0000u) : (ww[e >> 1] << 16), g * 16 + e);
              if (g == 0) { sort16_asc(grp);
#pragma unroll
                  for (int j = 0; j < 16; ++j) tk[j] = grp[15 - j]; }
              else top16_absorb(tk, grp); } }
        __syncthreads();
#pragma unroll
        for (int j = 0; j < 16; j += 4) *(LAS u32x4*)(lds + PE_TK + tid * 64 + j * 4) = (u32x4){tk[j], tk[j + 1], tk[j + 2], tk[j + 3]};
        __syncthreads();
        if (tid < 256) {
            const int tl = tid >> 3, h = tid & 7;
            const LAS unsigned char* ta = lds + PE_TK + (tl * 16 + h * 2) * 64; const LAS unsigned char* tb_ = ta + 64;
            float av[16], bv[16];
#pragma unroll
            for (int j = 0; j < 16; ++j) { av[j] = keyval(*(const LAS unsigned*)(ta + j * 4)); bv[j] = keyval(*(const LAS unsigned*)(tb_ + j * 4)); }
            unsigned bs[16];
            {
                unsigned cand[64];
#pragma unroll
                for (int q = 0; q < 64; ++q) cand[q] = 0u;
                int n = 0;
#pragma unroll
                for (int i = 0; i < 16; ++i)
#pragma unroll
                    for (int j = 0; j < 16 / (i + 1); ++j) { cand[n] = (fsort(av[i] + bv[j]) & 0xffffff00u) | (unsigned)(255 - (16 * i + j)); ++n; }
#pragma unroll
                for (int e = 0; e < 16; ++e) bs[e] = cand[e];
#pragma unroll
                for (int g = 1; g < 4; ++g) { unsigned grp[16];
#pragma unroll
                    for (int e = 0; e < 16; ++e) grp[e] = cand[16 * g + e];
                    top16_absorb(bs, grp); }
            }
            float ev[16]; unsigned be[16]; float sum = 0.f; const float v0 = funsort(bs[0] & 0xffffff00u);
#pragma unroll
            for (int j = 0; j < 16; ++j) { const unsigned code = 255u - (bs[j] & 0xffu), ci = code >> 4, cj = code & 15u;
                const unsigned ka = *(const LAS unsigned*)(ta + ci * 4), kb = *(const LAS unsigned*)(tb_ + cj * 4);
                be[j] = (127u - (ka & 0xffffu)) * 128u + (127u - (kb & 0xffffu));
                ev[j] = ex2((funsort(bs[j] & 0xffffff00u) - v0) * LOG2E); sum += ev[j]; }
            const float isum = rcp(sum);
            float su_[16];
#pragma unroll
            for (int j = 0; j < 16; ++j) { const f32x2 sc = ((const f32x2*)(a.ws + WS_SUV))[be[j]]; su_[j] = sc.x * (1.f / PEER_XS); ev[j] *= isum * sc.y; }
#pragma unroll
            for (int j = 0; j < 16; j += 4) { const size_t o = ((size_t)(t0 + tl) * 128 + h * 16 + j); *(u32x4*)((unsigned*)(a.ws + WS_EXG) + o) = (u32x4){be[j], be[j + 1], be[j + 2], be[j + 3]};
                *(f32x4*)((float*)(a.ws + WS_GTG) + o) = (f32x4){ev[j], ev[j + 1], ev[j + 2], ev[j + 3]};
                *(f32x4*)((float*)(a.ws + WS_SUG) + o) = (f32x4){su_[j], su_[j + 1], su_[j + 2], su_[j + 3]}; }
        }
    }
}


typedef int i32x8 __attribute__((ext_vector_type(8)));
typedef int i32x2 __attribute__((ext_vector_type(2)));
__device__ __forceinline__ void p12_peer_u(const Args& a, LAS unsigned char* lds) {
    const int tid = threadIdx.x, lane = tid & 63, wave = __builtin_amdgcn_readfirstlane(tid >> 6), bx = blockIdx.x;
    const int p = bx & 3, hb = (bx >> 2) & 1, q = bx >> 3, c = lane & 15, kg = lane >> 4, r8 = lane >> 3, s8 = lane & 7;
    const bf16_t* XN = (const bf16_t*)(a.ws + WS_XN); const unsigned* EXG = (const unsigned*)(a.ws + WS_EXG);
    const unsigned char* U = a.ws + WS_UBF + (size_t)p * (2 * MiB) + 16 * (s8 ^ r8);
    bf16_t* PART = (bf16_t*)(a.ws + WS_PART) + (size_t)p * T_ * 128;
    LAS unsigned char* wl = lds + wave * 16384;
    const float* SSH = (const float*)(a.ws + WS_SSH);
    const int aoff0 = c * 128 + 16 * ((kg) ^ (c & 7)), aoff1 = c * 128 + 16 * ((kg + 4) ^ (c & 7));
    const int SC1 = 0x7f7f7f7f;
    for (int qq = q; qq < 32; qq += (int)(gridDim.x >> 3)) {
        const size_t tb = (size_t)(2 * qq + hb) * 512 + wave * 64;
        u32x4 xw[2][4]; unsigned e0, e1; float ssh; f32x4 sg;
        { const bf16_t* xp = XN + tb * 1024 + 256 * p + 16 * kg;
#pragma unroll
          for (int j = 0; j < 2; ++j)
#pragma unroll
            for (int i = 0; i < 4; ++i) xw[j][i] = *(const u32x4*)(xp + 128 * j + 64 * (i >> 1) + 8 * (i & 1));
          e0 = EXG[tb * 128 + lane]; e1 = EXG[tb * 128 + 64 + lane]; ssh = SSH[tb];
          sg = *(const f32x4*)((const float*)(a.ws + WS_SUG) + tb * 128 + 16 * (c & 7) + 4 * kg); }
        for (int ti = 0; ti < 64; ++ti) {
            const size_t t = tb + ti, t1 = ti + 1 < 64 ? t + 1 : t;
            asm volatile("s_waitcnt lgkmcnt(0)" ::: "memory");
#pragma unroll
            for (int g = 0; g < 16; ++g) {
                const unsigned e = (unsigned)__shfl((int)(g < 8 ? e0 : e1), 8 * (g & 7) + r8);
                __builtin_amdgcn_global_load_lds((const unsigned*)(U + (size_t)e * 128), (LAS unsigned*)(wl + g * 1024), 16, 0, 0);
            }
            i32x8 bfr[2];
            { const float xs = rsq(ssh * (1.f / 1024.f) + EPS_) * PEER_XS;
#pragma unroll
              for (int j = 0; j < 2; ++j)
#pragma unroll
                for (int i = 0; i < 4; ++i) { float f[8]; unpack8(xw[j][i], f);
                    int w0 = 0, w1 = 0;
                    w0 = __builtin_amdgcn_cvt_pk_fp8_f32(f[0] * xs, f[1] * xs, w0, false); w0 = __builtin_amdgcn_cvt_pk_fp8_f32(f[2] * xs, f[3] * xs, w0, true);
                    w1 = __builtin_amdgcn_cvt_pk_fp8_f32(f[4] * xs, f[5] * xs, w1, false); w1 = __builtin_amdgcn_cvt_pk_fp8_f32(f[6] * xs, f[7] * xs, w1, true);
                    bfr[j][2 * i] = w0; bfr[j][2 * i + 1] = w1; } }
            const f32x4 sgc = sg;
            { const bf16_t* xp = XN + t1 * 1024 + 256 * p + 16 * kg;
#pragma unroll
              for (int j = 0; j < 2; ++j)
#pragma unroll
                for (int i = 0; i < 4; ++i) xw[j][i] = *(const u32x4*)(xp + 128 * j + 64 * (i >> 1) + 8 * (i & 1));
              e0 = EXG[t1 * 128 + lane]; e1 = EXG[t1 * 128 + 64 + lane]; ssh = SSH[t1];
              sg = *(const f32x4*)((const float*)(a.ws + WS_SUG) + t1 * 128 + 16 * (c & 7) + 4 * kg); }
            asm volatile("s_waitcnt vmcnt(0)" ::: "memory");
            f32x4 acc[8];
#pragma unroll
            for (int rb = 0; rb < 8; ++rb) {
                const u32x4 a0 = *(const LAS u32x4*)(wl + rb * 2048 + aoff0), a1 = *(const LAS u32x4*)(wl + rb * 2048 + aoff1);
                f32x4 v = (f32x4){0.f, 0.f, 0.f, 0.f};
                v = __builtin_amdgcn_mfma_scale_f32_16x16x128_f8f6f4((i32x8){(int)a0.x, (int)a0.y, (int)a0.z, (int)a0.w, 0, 0, 0, 0}, bfr[0], v, 4, 0, 0, SC1, 0, SC1);
                v = __builtin_amdgcn_mfma_scale_f32_16x16x128_f8f6f4((i32x8){(int)a1.x, (int)a1.y, (int)a1.z, (int)a1.w, 0, 0, 0, 0}, bfr[1], v, 4, 0, 0, SC1, 0, SC1);
                acc[rb] = v;
            }
            f32x4 v = acc[0];
#pragma unroll
            for (int rb = 1; rb < 8; ++rb) { const bool sel = (c == rb); v.x = sel ? acc[rb].x : v.x; v.y = sel ? acc[rb].y : v.y; v.z = sel ? acc[rb].z : v.z; v.w = sel ? acc[rb].w : v.w; }
            if (c < 8) *(u32x2*)(PART + t * 128 + 16 * c + 4 * kg) = (u32x2){pk2(v.x * sgc.x, v.y * sgc.y), pk2(v.z * sgc.z, v.w * sgc.w)};
        }
    }
}
__device__ __forceinline__ void p13_peer_v_mfma(const Args& a, LAS unsigned char* lds) {
    const int tid = threadIdx.x, lane = tid & 63, wave = __builtin_amdgcn_readfirstlane(tid >> 6), bx = blockIdx.x;
    const int p = bx & 3, hb = (bx >> 2) & 1, q = bx >> 3, n16 = lane & 15, kg = lane >> 4, r8 = lane >> 3, s8 = lane & 7;
    const unsigned* __restrict__ EXG = (const unsigned*)(a.ws + WS_EXG); const float* __restrict__ GTG = (const float*)(a.ws + WS_GTG); const bf16_t* __restrict__ PART = (const bf16_t*)(a.ws + WS_PART);
    const unsigned char* V0 = a.ws + WS_VBF + (size_t)p * (2 * MiB) + 16 * (s8 ^ (r8 >> 1)); const unsigned char* V1 = a.ws + WS_VBF + (size_t)p * (2 * MiB) + 16 * (s8 ^ (r8 >> 1) ^ 4);
    LAS unsigned char* wl = lds + wave * 16384;
    LAS unsigned char* w8 = lds + 131072 + wave * 128;
    const int trb0 = (32 * kg + n16) * 128, trb1 = trb0 + 16 * 128, sw = n16 >> 1;
    const int SC1 = 0x7f7f7f7f;
    for (int qq = q; qq < 32; qq += (int)(gridDim.x >> 3)) {
        const size_t tb = (size_t)(2 * qq + hb) * 512 + wave * 64;
        unsigned e0 = EXG[tb * 128 + lane], e1 = EXG[tb * 128 + 64 + lane];
        unsigned e0n = EXG[(tb + 1) * 128 + lane], e1n = EXG[(tb + 1) * 128 + 64 + lane];
        bf16_t pa0[4], pa1[4]; float g0, g1;
#pragma unroll
        for (int pp = 0; pp < 4; ++pp) { pa0[pp] = PART[((size_t)pp * T_ + tb) * 128 + lane]; pa1[pp] = PART[((size_t)pp * T_ + tb) * 128 + 64 + lane]; }
        g0 = GTG[tb * 128 + lane]; g1 = GTG[tb * 128 + 64 + lane];
        for (int ti = 0; ti < 64; ++ti) {
            const size_t t = tb + ti;
            asm volatile("s_waitcnt lgkmcnt(0)" ::: "memory");
#pragma unroll
            for (int g = 0; g < 16; ++g) {
                const unsigned e = (unsigned)__shfl((int)(g < 8 ? e0 : e1), 8 * (g & 7) + r8);
                __builtin_amdgcn_global_load_lds((const unsigned*)(((g & 1) ? V1 : V0) + (size_t)e * 128), (LAS unsigned*)(wl + g * 1024), 16, 0, 0);
            }
            float a0 = 0.f, a1 = 0.f;
#pragma unroll
            for (int pp = 0; pp < 4; ++pp) { a0 += bf1(pa0[pp]); a1 += bf1(pa1[pp]); }
            const float w0 = g0 * gelu_tanh(a0), w1 = g1 * gelu_tanh(a1);
            const size_t t1 = ti + 1 < 64 ? t + 1 : t, t2 = ti + 2 < 64 ? t + 2 : t;
#pragma unroll
            for (int pp = 0; pp < 4; ++pp) { pa0[pp] = PART[((size_t)pp * T_ + t1) * 128 + lane]; pa1[pp] = PART[((size_t)pp * T_ + t1) * 128 + 64 + lane]; }
            g0 = GTG[t1 * 128 + lane]; g1 = GTG[t1 * 128 + 64 + lane];
            const unsigned e0nn = EXG[t2 * 128 + lane], e1nn = EXG[t2 * 128 + 64 + lane];
            const f32x4 hv = *(const f32x4*)(a.out + t * 1024 + 256 * p + 16 * n16 + 4 * kg);
            float wm = fmaxf(fabsf(w0), fabsf(w1));
#pragma unroll
            for (int o = 1; o < 64; o <<= 1) wm = fmaxf(wm, __shfl_xor(wm, o));
            int be = (int)(__builtin_bit_cast(unsigned, wm) >> 23); be = be < 16 ? 16 : (be > 240 ? 240 : be);
            const float sc = __builtin_bit_cast(float, (unsigned)(261 - be) << 23), isc = __builtin_bit_cast(float, (unsigned)(be - 7) << 23);
            const int pk = __builtin_amdgcn_cvt_pk_fp8_f32(w0 * sc, w1 * sc, 0, false);
            w8[lane] = (unsigned char)(pk & 0xff); w8[64 + lane] = (unsigned char)((pk >> 8) & 0xff);
            asm volatile("s_waitcnt vmcnt(0) lgkmcnt(0)" ::: "memory");
            const u32x4 aw0 = *(const LAS u32x4*)(w8 + 16 * kg), aw1 = *(const LAS u32x4*)(w8 + 64 + 16 * kg);
            const i32x8 af = (i32x8){(int)aw0.x, (int)aw0.y, (int)aw0.z, (int)aw0.w, (int)aw1.x, (int)aw1.y, (int)aw1.z, (int)aw1.w};
            f32x4 v = (f32x4){0.f, 0.f, 0.f, 0.f};
#pragma unroll
            for (int mf = 0; mf < 16; ++mf) {
                const int co = 16 * ((mf >> 1) ^ sw) + 8 * (mf & 1);
                const i32x2 b0 = __builtin_amdgcn_ds_read_tr4_b64_v2i32((LAS i32x2*)(wl + trb0 + co)), b1 = __builtin_amdgcn_ds_read_tr4_b64_v2i32((LAS i32x2*)(wl + trb1 + co));
                const f32x4 d = __builtin_amdgcn_mfma_scale_f32_16x16x128_f8f6f4((i32x8){b0.x, b0.y, b1.x, b1.y, 0, 0, 0, 0}, af, (f32x4){0.f, 0.f, 0.f, 0.f}, 4, 0, 0, SC1, 0, SC1);
                const bool sel = (n16 == mf); v.x = sel ? d.x : v.x; v.y = sel ? d.y : v.y; v.z = sel ? d.z : v.z; v.w = sel ? d.w : v.w;
            }
            *(f32x4*)(a.out + t * 1024 + 256 * p + 16 * n16 + 4 * kg) = hv + v * isc;
            e0 = e0n; e1 = e1n; e0n = e0nn; e1n = e1nn;
        }
    }
}

__global__ void __launch_bounds__(512, 2) fwd_kernel(Args a) {
    extern __shared__ __attribute__((aligned(16))) unsigned char lds_raw[];
    LAS unsigned char* lds = (LAS unsigned char*)lds_raw;
    volatile LAS unsigned* MISC = (volatile LAS unsigned*)(lds + MISC_OFF);
    const int tid = threadIdx.x, G = gridDim.x, bx = blockIdx.x;
    if (tid < 16) MISC[tid] = 0u;
    __syncthreads();
    unsigned char* ws = a.ws;
    XcdBarrier bar; bar.bar = (unsigned*)(ws + WS_CTL) + 4096; bar.x = 0; bar.st = nullptr;
    if (!MK_PER_PHASE) bar = xcd_barrier_post((unsigned*)(ws + WS_CTL) + 4096, MISC + 8);
    const int lo = a.ph_lo, hi = a.ph_hi;
#define IN(k) (lo <= (k) && (k) < hi)
#define SEAM(k) do { if (!MK_PER_PHASE && IN((k) + 1)) xcd_barrier(bar); if (DBG_TIME >= 0 && bx == 0 && tid == 0) ((unsigned long long*)(ws + WS_CTL))[100 + (k) + 1] = __builtin_amdgcn_s_memrealtime(); } while (0)
    unsigned char* dob = (unsigned char*)a.out;

    if (DBG_TIME >= 0 && bx == 0 && tid == 0) ((unsigned long long*)(ws + WS_CTL))[100] = __builtin_amdgcn_s_memrealtime();
    if (IN(0)) { p0_prologue(a, lds); SEAM(0); }
    if (IN(1)) {
        { pg8::Gemm g{1024, 1024, 1024}; pg8::SchedStd S{128, 23, G, bx, (const char*)(dob + DO_N), (const char*)(ws + WS_WIN), (size_t)256 * 1024 * 2, (size_t)256 * 1024 * 2, 0};
          pg8::EpiProj E{(bf16_t*)(ws + WS_RA), (bf16_t*)(ws + WS_RB), (bf16_t*)(ws + WS_QRET), (bf16_t*)(ws + WS_KRET), (bf16_t*)(dob + DO_GS), (bf16_t*)(dob + DO_XQ),
                         (float*)(ws + WS_SSX), a.pos, (const f32x2*)(ws + WS_CS64)};
          pg8::gemm_phase(lds, g, S, E); }
        { pg8::Gemm g{1024, 1024, 1024}; pg8::SchedStd S{8, 4, G, (bx + G - 128 % G) % G, (const char*)(ws + WS_MEMN), (const char*)(ws + WS_WMKV), (size_t)256 * 1024 * 2, (size_t)256 * 1024 * 2, 0};
          pg8::EpiBf16 E{(bf16_t*)(ws + WS_KVM), 1024};
          pg8::gemm_phase(lds, g, S, E); }
        SEAM(1);
    }
    if (IN(2)) { p2_post_proj(a, lds); SEAM(2); }
    if (IN(3)) {
        { pg8::Gemm g{512, 512, 512}; pg8::SchedStd S{128, 7, G, bx, (const char*)(dob + DO_CQKV), (const char*)(ws + WS_WUP), (size_t)256 * 512 * 2, (size_t)256 * 512 * 2, 0};
          pg8::EpiBf16 E{(bf16_t*)(ws + WS_UP), NUP};
          pg8::gemm_phase(lds, g, S, E); }
        p3_ret_incr(a);
        SEAM(3);
    }
    if (IN(4)) { p4_post_up(a, lds); SEAM(4); }
    if (IN(5)) { p5_mixers(a, lds); SEAM(5); if (DBG_CHECK) { dbg_ret_check(a); xcd_barrier(bar);
        if (bx == 0 && tid < 64) { const unsigned long long kk = __hip_atomic_load((unsigned long long*)(ws + WS_CTL) + 32, __ATOMIC_RELAXED, __HIP_MEMORY_SCOPE_AGENT); dbg_ret_eval(a, (int)(unsigned)kk); } } }
    if (IN(6)) {
        pg8::Gemm g{512, 512, 512}; pg8::SchedG4 S{G, bx, (const char*)(ws + WS_OMLA), (const char*)(dob + DO_GS), (const char*)(dob + DO_XQ), (const char*)(ws + WS_WO3)};
        pg8::EpiGate E{(bf16_t*)(ws + WS_RB), (bf16_t*)(ws + WS_MERGED)};
        pg8::gemm_phase(lds, g, S, E);
        SEAM(6);
    }
    if (IN(7)) {
        pg8::Gemm g{1024, 1024, 1024}; pg8::SchedStd S{128, 4, G, bx, (const char*)(ws + WS_MERGED), (const char*)(ws + WS_WOUT), (size_t)256 * 1024 * 2, (size_t)256 * 1024 * 2, 0};
        pg8::EpiRes E{a.out, a.x, (bf16_t*)(ws + WS_XN), (float*)(ws + WS_SSH)};
        pg8::gemm_phase(lds, g, S, E);
        table_fp4(a, a.peer_v, a.ws + WS_VBF, (float*)(a.ws + WS_SUV) + 1, nullptr);
        table_fp4(a, a.peer_u, a.ws + WS_UBF, (float*)(a.ws + WS_SUV), a.ffn_norm_g);
        SEAM(7);
    }
    if (IN(9)) {
        pg8::Gemm g{1024, 1024, 1024}; pg8::SchedStd S{128, 8, G, bx, (const char*)(ws + WS_XN), (const char*)(ws + WS_WQ), (size_t)256 * 1024 * 2, (size_t)256 * 1024 * 2, 0};
        pg8::EpiBf16S E{(bf16_t*)(ws + WS_PQ), 2048, (const float*)(ws + WS_SSH)};
        pg8::gemm_phase(lds, g, S, E);
        SEAM(9);
    }
    if (IN(11)) { p11a_topk(a, lds); SEAM(11); }
    if (IN(12)) { p12_peer_u(a, lds); SEAM(12); }
    if (IN(13)) { p13_peer_v_mfma(a, lds);
        if (DBG_TIME >= 0) { xcd_barrier(bar); if (bx == 0 && tid == 0) { const unsigned long long* st = (const unsigned long long*)(ws + WS_CTL) + 100; const unsigned long long te = __builtin_amdgcn_s_memrealtime();
            const unsigned long long d = DBG_TIME == 30 ? te - st[0] : DBG_TIME >= 20 ? ((const unsigned long long*)(ws + WS_CTL))[130] : (DBG_TIME == 13 ? te : st[DBG_TIME + 1]) - st[DBG_TIME]; a.out[0] += (float)d * 0.01f * DBG_TSCALE; } } }
#undef IN
#undef SEAM
}

extern "C" void kernel_launch(void* const* d_in, const int* in_sizes, int n_in, void* d_out, int out_size, void* d_ws, size_t ws_size, hipStream_t stream) {
    static int grid = 0;
    if (grid == 0) {
        if (n_in != 25 || out_size != T_ * D_ || ws_size < WS_END) { fprintf(stderr, "kernel_launch: unexpected shapes (n_in %d, out %d, ws %zu)\n", n_in, out_size, ws_size); grid = -1; return; }
        int dev = 0, cus = 0, per_cu = 0;
        if (hipGetDevice(&dev) != hipSuccess || hipDeviceGetAttribute(&cus, hipDeviceAttributeMultiprocessorCount, dev) != hipSuccess) { grid = -1; return; }
        if (hipFuncSetAttribute((const void*)fwd_kernel, hipFuncAttributeMaxDynamicSharedMemorySize, LDS_BYTES) != hipSuccess) { fprintf(stderr, "kernel_launch: hipFuncSetAttribute failed\n"); grid = -1; return; }
        if (hipOccupancyMaxActiveBlocksPerMultiprocessor(&per_cu, (const void*)fwd_kernel, 512, LDS_BYTES) != hipSuccess || per_cu < 1) fprintf(stderr, "kernel_launch: occupancy query reports %d\n", per_cu);
        (void)hipGetLastError();
        grid = cus;
    }
    if (grid < 0) return;
    if (hipMemsetAsync((char*)d_ws + WS_CTL, 0, CTL_ZERO_BYTES, stream) != hipSuccess) return;
    Args a{};
    a.x = (const float*)d_in[0]; a.mem = (const float*)d_in[1]; a.pos = (const int*)d_in[2];
    a.attn_norm_g = (const float*)d_in[3]; a.w_in = (const float*)d_in[4]; a.mla_q_norm_g = (const float*)d_in[5]; a.w_uq = (const float*)d_in[6];
    a.mla_kv_norm_g = (const float*)d_in[7]; a.w_ukv = (const float*)d_in[8]; a.mla_qn_g = (const float*)d_in[9]; a.mla_kn_g = (const float*)d_in[10];
    a.w_o_mla = (const float*)d_in[11]; a.ret_gn_g = (const float*)d_in[12]; a.w_o_ret = (const float*)d_in[13]; a.mem_norm_g = (const float*)d_in[14];
    a.w_mem_kv = (const float*)d_in[15]; a.x_qn_g = (const float*)d_in[16]; a.x_kn_g = (const float*)d_in[17]; a.w_o_cross = (const float*)d_in[18];
    a.w_out = (const float*)d_in[19]; a.ffn_norm_g = (const float*)d_in[20]; a.peer_w_q = (const float*)d_in[21]; a.peer_keys = (const float*)d_in[22];
    a.peer_u = (const float*)d_in[23]; a.peer_v = (const float*)d_in[24];
    a.out = (float*)d_out; a.ws = (unsigned char*)d_ws;
    for (int i = 0; i < 16; ++i) a.invf32[i] = powf(10000.0f, -(float)(2 * i) / 32.0f);
    for (int i = 0; i < 32; ++i) a.invf64[i] = powf(10000.0f, -(float)(2 * i) / 64.0f);
    for (int h = 0; h < 4; ++h) a.lg2g[h] = (float)std::log2(1.0 - std::exp2(-5.0 - (double)h));
#if MK_PER_PHASE
    for (int p = 0; p < NPHASE; ++p) { a.ph_lo = p; a.ph_hi = p + 1; hipLaunchKernelGGL(fwd_kernel, dim3(grid), dim3(512), LDS_BYTES, stream, a); }
#else
    a.ph_lo = 0; a.ph_hi = NPHASE;
    hipLaunchKernelGGL(fwd_kernel, dim3(grid), dim3(512), LDS_BYTES, stream, a);
#endif
    const hipError_t le = hipPeekAtLastError();
    if (le != hipSuccess) fprintf(stderr, "kernel_launch: launch failed: %s\n", hipGetErrorName(le));
}
```
